# Optimizing an MI355X kernel written in HIP

```python
import jax, jax.numpy as jnp
from jax import lax
import numpy as np

D_MODEL = 1024
BATCH = 8
SEQ = 2048
DEPTH = 4

GRID_W = 64
CTX_LEN = 256
HEAD_DIM = 64
ROPE_THETA = 10000.0
EPS = 1e-6
Q_BLOCK = 128
NEG_INF = -1e30
ATTN_SCALE = HEAD_DIM ** -0.5

A_HEADS = 8
A_KV_HEADS = 2
B_HEADS = 8
B_KV_HEADS = 2
B_WINDOW = 128
C_WIDTH = 512
C_CONV = 31
D_HEADS = 8
NA_KH = 8
NA_KW = 16

A_Q = A_HEADS * HEAD_DIM
A_KV = A_KV_HEADS * HEAD_DIM
B_Q = B_HEADS * HEAD_DIM
B_KV = B_KV_HEADS * HEAD_DIM
D_W = D_HEADS * HEAD_DIM
EVEN_WIDTHS = (A_Q, A_KV, A_KV, A_Q, B_Q, B_KV, B_KV, B_Q)
ODD_WIDTHS = (C_WIDTH, C_WIDTH, C_WIDTH, D_W, D_W, D_W, D_W)
EVEN_IN = sum(EVEN_WIDTHS)
ODD_IN = sum(ODD_WIDTHS)
EVEN_MIX = A_Q + B_Q
ODD_MIX = C_WIDTH + D_W

kernel_name = "hybrid_dit_ctx_prefix_attn_conv_natten"


def rms_norm(x, g):
    xf = x.astype(jnp.float32)
    y = xf * lax.rsqrt(jnp.mean(xf * xf, axis=-1, keepdims=True) + EPS)
    return (y * g.astype(jnp.float32)).astype(x.dtype)


def layer_norm(x, g, b):
    xf = x.astype(jnp.float32)
    mu = jnp.mean(xf, axis=-1, keepdims=True)
    var = jnp.mean(jnp.square(xf - mu), axis=-1, keepdims=True)
    y = (xf - mu) * lax.rsqrt(var + EPS)
    return (y * g.astype(jnp.float32) + b.astype(jnp.float32)).astype(x.dtype)


def split_cols(h, widths):
    offs = [int(o) for o in np.cumsum(widths)[:-1]]
    return jnp.split(h, offs, axis=-1)


def heads(t, n_heads):
    return t.reshape(t.shape[:-1] + (n_heads, HEAD_DIM))


def group(q, kv_heads):
    return q.reshape(q.shape[:-2] + (kv_heads, q.shape[-2] // kv_heads, HEAD_DIM))


def axial_rope_tables(n):
    t = jnp.arange(n)
    row = (t // GRID_W).astype(jnp.float32)
    col = (t % GRID_W).astype(jnp.float32)
    half = HEAD_DIM // 2
    freqs = ROPE_THETA ** (-jnp.arange(0, half, 2, dtype=jnp.float32) / half)
    ang = jnp.concatenate([row[:, None] * freqs, col[:, None] * freqs], axis=-1)
    return jnp.cos(ang), jnp.sin(ang)


def apply_rope(x, cos, sin):
    xf = x.astype(jnp.float32)
    x1, x2 = xf[..., 0::2], xf[..., 1::2]
    c, s = cos[None, :, None, :], sin[None, :, None, :]
    out = jnp.stack([x1 * c - x2 * s, x1 * s + x2 * c], axis=-1).reshape(x.shape)
    return out.astype(x.dtype)


def gqa_attend(q, k, v, bias=None, sink=None):
    s = jnp.einsum("bqhgd,bkhd->bhgqk", q, k, preferred_element_type=jnp.float32) * ATTN_SCALE
    if bias is not None:
        s = s + bias
    if sink is not None:
        sink_col = jnp.broadcast_to(sink.astype(jnp.float32)[None, :, :, None, None], s.shape[:-1] + (1,))
        p = jax.nn.softmax(jnp.concatenate([s, sink_col], axis=-1), axis=-1)[..., :-1]
    else:
        p = jax.nn.softmax(s, axis=-1)
    return jnp.einsum("bhgqk,bkhd->bqhgd", p.astype(v.dtype), v)


def even_mixer(h_lat, h_ctx, w_in, w_out, q_gain, k_gain, sink, cos, sin, update_ctx):
    bsz, n, _ = h_lat.shape
    ctx_len = h_ctx.shape[1]
    n_blk = n // Q_BLOCK
    ga, gb = A_HEADS // A_KV_HEADS, B_HEADS // B_KV_HEADS
    sink = sink.reshape(B_KV_HEADS, gb)

    def project(h):
        aq, ak, av, ag, bq, bk, bv, bg = split_cols(h @ w_in, EVEN_WIDTHS)
        aq = rms_norm(heads(aq, A_HEADS), q_gain)
        ak = rms_norm(heads(ak, A_KV_HEADS), k_gain)
        return (aq, ak, heads(av, A_KV_HEADS), ag,
                heads(bq, B_HEADS), heads(bk, B_KV_HEADS), heads(bv, B_KV_HEADS), bg)

    aq, ak, av, ag, bq, bk, bv, bg = project(h_lat)
    c_aq, c_ak, c_av, c_ag, c_bq, c_bk, c_bv, c_bg = project(h_ctx)
    aq, ak, bq, bk = (apply_rope(t, cos, sin) for t in (aq, ak, bq, bk))

    ka = jnp.concatenate([c_ak, ak], axis=1)
    va = jnp.concatenate([c_av, av], axis=1)
    qa_blk = jnp.moveaxis(group(aq, A_KV_HEADS).reshape(bsz, n_blk, Q_BLOCK, A_KV_HEADS, ga, HEAD_DIM), 1, 0)
    oa = lax.map(lambda qb: gqa_attend(qb, ka, va), qa_blk)
    oa = jnp.moveaxis(oa, 0, 1).reshape(bsz, n, A_Q)

    band = Q_BLOCK + 2 * B_WINDOW
    kb_pad = jnp.pad(bk, ((0, 0), (B_WINDOW, B_WINDOW), (0, 0), (0, 0)))
    vb_pad = jnp.pad(bv, ((0, 0), (B_WINDOW, B_WINDOW), (0, 0), (0, 0)))
    rel = jnp.arange(band)[None, :] - B_WINDOW - jnp.arange(Q_BLOCK)[:, None]
    in_band = jnp.abs(rel) <= B_WINDOW
    ctx_open = jnp.zeros((Q_BLOCK, ctx_len), jnp.float32)
    qb_blk = jnp.moveaxis(group(bq, B_KV_HEADS).reshape(bsz, n_blk, Q_BLOCK, B_KV_HEADS, gb, HEAD_DIM), 1, 0)

    def b_block(args):
        blk, qb = args
        start = blk * Q_BLOCK
        kpos = start - B_WINDOW + jnp.arange(band)
        valid = in_band & ((kpos >= 0) & (kpos < n))[None, :]
        bias = jnp.concatenate([ctx_open, jnp.where(valid, 0.0, NEG_INF)], axis=-1)
        kk = jnp.concatenate([c_bk, lax.dynamic_slice_in_dim(kb_pad, start, band, axis=1)], axis=1)
        vv = jnp.concatenate([c_bv, lax.dynamic_slice_in_dim(vb_pad, start, band, axis=1)], axis=1)
        return gqa_attend(qb, kk, vv, bias, sink)

    ob = lax.map(b_block, (jnp.arange(n_blk), qb_blk))
    ob = jnp.moveaxis(ob, 0, 1).reshape(bsz, n, B_Q)

    y_lat = jnp.concatenate([oa * jax.nn.silu(ag), ob * jax.nn.silu(bg)], axis=-1) @ w_out
    if not update_ctx:
        return y_lat, None
    oa_c = gqa_attend(group(c_aq, A_KV_HEADS), c_ak, c_av).reshape(bsz, ctx_len, A_Q)
    ob_c = gqa_attend(group(c_bq, B_KV_HEADS), c_bk, c_bv, sink=sink).reshape(bsz, ctx_len, B_Q)
    y_ctx = jnp.concatenate([oa_c * jax.nn.silu(c_ag), ob_c * jax.nn.silu(c_bg)], axis=-1) @ w_out
    return y_lat, y_ctx


def conformer_conv(val, glu_gate, silu_gate, dw_w, dw_b, ln_g, ln_b):
    u = val * jax.nn.sigmoid(glu_gate)
    u = lax.conv_general_dilated(u, dw_w.reshape(C_CONV, 1, C_WIDTH), window_strides=(1,),
                                 padding=[(C_CONV // 2, C_CONV // 2)],
                                 dimension_numbers=("NWC", "WIO", "NWC"),
                                 feature_group_count=C_WIDTH) + dw_b
    u = jax.nn.silu(layer_norm(u, ln_g, ln_b))
    return u * jax.nn.silu(silu_gate)


def odd_mixer(h_lat, h_ctx, w_in, w_out, dw_w, dw_b, ln_g, ln_b, rpb, update_ctx):
    bsz, n, _ = h_lat.shape
    ctx_len = h_ctx.shape[1]
    rows = n // GRID_W
    kh = min(NA_KH, rows)

    cv, cgl, cg, dq, dk, dv, dg = split_cols(h_lat @ w_in, ODD_WIDTHS)
    x_cv, x_cgl, x_cg, x_dq, x_dk, x_dv, x_dg = split_cols(h_ctx @ w_in, ODD_WIDTHS)
    c_dk, c_dv = heads(x_dk, D_HEADS), heads(x_dv, D_HEADS)

    oc = conformer_conv(cv, cgl, cg, dw_w, dw_b, ln_g, ln_b)

    q_rows = jnp.moveaxis(heads(dq, D_HEADS).reshape(bsz, rows, GRID_W, D_HEADS, HEAD_DIM), 1, 0)
    k_grid = heads(dk, D_HEADS).reshape(bsz, rows, GRID_W, D_HEADS, HEAD_DIM)
    v_grid = heads(dv, D_HEADS).reshape(bsz, rows, GRID_W, D_HEADS, HEAD_DIM)
    cols = jnp.arange(GRID_W)
    col_start = jnp.clip(cols - NA_KW // 2, 0, GRID_W - NA_KW)
    col_in = (cols[None, :] >= col_start[:, None]) & (cols[None, :] < col_start[:, None] + NA_KW)
    col_mask = jnp.where(col_in, 0.0, NEG_INF)
    dc_idx = jnp.clip(cols[None, :] - cols[:, None] + NA_KW - 1, 0, 2 * NA_KW - 2)
    rpb = rpb.astype(jnp.float32)
    ctx_open = jnp.zeros((D_HEADS, GRID_W, ctx_len), jnp.float32)

    def d_row(args):
        r, qr = args
        rs = jnp.clip(r - kh // 2, 0, rows - kh)
        kr = lax.dynamic_slice_in_dim(k_grid, rs, kh, axis=1).reshape(bsz, kh * GRID_W, D_HEADS, HEAD_DIM)
        vr = lax.dynamic_slice_in_dim(v_grid, rs, kh, axis=1).reshape(bsz, kh * GRID_W, D_HEADS, HEAD_DIM)
        dr_idx = rs + jnp.arange(kh) - r + NA_KH - 1
        bias = rpb[:, dr_idx][:, :, dc_idx] + col_mask[None, None]
        bias = jnp.transpose(bias, (0, 2, 1, 3)).reshape(D_HEADS, GRID_W, kh * GRID_W)
        bias = jnp.concatenate([ctx_open, bias], axis=-1)[None, :, None]
        kk = jnp.concatenate([c_dk, kr], axis=1)
        vv = jnp.concatenate([c_dv, vr], axis=1)
        return gqa_attend(qr[:, :, :, None, :], kk, vv, bias).reshape(bsz, GRID_W, D_W)

    od = lax.map(d_row, (jnp.arange(rows), q_rows))
    od = jnp.moveaxis(od, 0, 1).reshape(bsz, n, D_W)

    y_lat = jnp.concatenate([oc, od * jax.nn.silu(dg)], axis=-1) @ w_out
    if not update_ctx:
        return y_lat, None
    oc_c = conformer_conv(x_cv, x_cgl, x_cg, dw_w, dw_b, ln_g, ln_b)
    od_c = gqa_attend(heads(x_dq, D_HEADS)[:, :, :, None, :], c_dk, c_dv).reshape(bsz, ctx_len, D_W)
    y_ctx = jnp.concatenate([oc_c, od_c * jax.nn.silu(x_dg)], axis=-1) @ w_out
    return y_lat, y_ctx


def modulation(cond, w, b):
    m = jax.nn.silu(cond) @ w + b
    return jnp.split(m, 3, axis=-1)


def setup_inputs(seed: int = 0) -> dict:
    key = jax.random.key(seed)
    ks = jax.random.split(key, 24)
    n_even = (DEPTH + 1) // 2
    n_odd = DEPTH // 2
    f32 = jnp.float32

    def nrm(k, shape, scale):
        return jax.random.normal(k, shape, f32) * scale

    return {
        "x": nrm(ks[0], (BATCH, SEQ, D_MODEL), 1.0),
        "c": nrm(ks[1], (BATCH, D_MODEL), 1.0),
        "ctx": nrm(ks[2], (BATCH, CTX_LEN, D_MODEL), 1.0),
        "c_ctx": nrm(ks[3], (D_MODEL,), 1.0),
        "mod_w": nrm(ks[4], (DEPTH, D_MODEL, 3 * D_MODEL), 0.5 * D_MODEL ** -0.5),
        "mod_b": nrm(ks[5], (DEPTH, 3 * D_MODEL), 0.02),
        "norm_g": 1.0 + nrm(ks[6], (DEPTH, D_MODEL), 0.05),
        "ev_w_in": nrm(ks[7], (n_even, D_MODEL, EVEN_IN), D_MODEL ** -0.5),
        "ev_w_out": nrm(ks[8], (n_even, EVEN_MIX, D_MODEL), EVEN_MIX ** -0.5),
        "a_q_gain": 1.0 + nrm(ks[9], (n_even, HEAD_DIM), 0.05),
        "a_k_gain": 1.0 + nrm(ks[10], (n_even, HEAD_DIM), 0.05),
        "b_sink": nrm(ks[11], (n_even, B_HEADS), 0.5),
        "od_w_in": nrm(ks[12], (n_odd, D_MODEL, ODD_IN), D_MODEL ** -0.5),
        "od_w_out": nrm(ks[13], (n_odd, ODD_MIX, D_MODEL), ODD_MIX ** -0.5),
        "c_dw_w": nrm(ks[14], (n_odd, C_CONV, C_WIDTH), C_CONV ** -0.5),
        "c_dw_b": nrm(ks[15], (n_odd, C_WIDTH), 0.02),
        "c_ln_g": 1.0 + nrm(ks[16], (n_odd, C_WIDTH), 0.05),
        "c_ln_b": nrm(ks[17], (n_odd, C_WIDTH), 0.02),
        "d_rpb": nrm(ks[18], (n_odd, D_HEADS, 2 * NA_KH - 1, 2 * NA_KW - 1), 0.1),
        "final_g": 1.0 + nrm(ks[19], (D_MODEL,), 0.05),
    }


def reference(x, c, ctx, c_ctx, mod_w, mod_b, norm_g, ev_w_in, ev_w_out, a_q_gain, a_k_gain, b_sink,
              od_w_in, od_w_out, c_dw_w, c_dw_b, c_ln_g, c_ln_b, d_rpb, final_g):
    n = x.shape[1]
    cos, sin = axial_rope_tables(n)
    x_lat, x_ctx = x, ctx
    for i in range(DEPTH):
        update_ctx = i < DEPTH - 1
        sh_l, sc_l, g_l = modulation(c, mod_w[i], mod_b[i])
        sh_c, sc_c, g_c = modulation(c_ctx, mod_w[i], mod_b[i])
        h_lat = rms_norm(x_lat, norm_g[i]) * (1.0 + sc_l[:, None, :]) + sh_l[:, None, :]
        h_ctx = rms_norm(x_ctx, norm_g[i]) * (1.0 + sc_c) + sh_c
        j = i // 2
        if i % 2 == 0:
            y_lat, y_ctx = even_mixer(h_lat, h_ctx, ev_w_in[j], ev_w_out[j], a_q_gain[j], a_k_gain[j],
                                      b_sink[j], cos, sin, update_ctx)
        else:
            y_lat, y_ctx = odd_mixer(h_lat, h_ctx, od_w_in[j], od_w_out[j], c_dw_w[j], c_dw_b[j],
                                     c_ln_g[j], c_ln_b[j], d_rpb[j], update_ctx)
        x_lat = x_lat + g_l[:, None, :] * y_lat
        if update_ctx:
            x_ctx = x_ctx + g_c * y_ctx
    return rms_norm(x_lat, final_g)
```

```cpp
#include <hip/hip_runtime.h>
#include <hip/hip_cooperative_groups.h>
#include <cstdint>
#include <cstdio>

#ifndef MULTI_LAUNCH
#define MULTI_LAUNCH 0
#endif

#define DI __device__ __forceinline__
#define LAS __attribute__((address_space(3)))

typedef unsigned short bf16_t;
typedef short bf16x8 __attribute__((ext_vector_type(8)));
typedef float f32x16 __attribute__((ext_vector_type(16)));
typedef float f32x4 __attribute__((ext_vector_type(4)));
typedef float f32x2 __attribute__((ext_vector_type(2)));
typedef unsigned u32x4 __attribute__((ext_vector_type(4)));
typedef unsigned u32x2 __attribute__((ext_vector_type(2)));
typedef __bf16 bf16v2 __attribute__((ext_vector_type(2)));

constexpr int NB = 8, SEQ = 2048, DM = 1024, CTX = 256, TB = 2304, MROWS = NB * TB;
constexpr float EPS = 1e-6f, LOG2E = 1.4426950408889634f;
constexpr int LROW = 144;
constexpr int GT_BYTES = 128 * LROW;
constexpr int LDS_BYTES = 46080;

struct Params {
    const float *x, *c, *ctx, *c_ctx, *mod_w, *mod_b, *norm_g, *ev_w_in, *ev_w_out, *a_q_gain, *a_k_gain, *b_sink,
        *od_w_in, *od_w_out, *c_dw_w, *c_dw_b, *c_ln_g, *c_ln_b, *d_rpb, *final_g;
    float* out;
    unsigned* bar;
    float* mvec;
    float* rope;
    bf16_t *wt_ev_in, *wt_ev_out, *wt_od_in, *wt_od_out;
    float* xctx;
    bf16_t* h;
    bf16_t* qbuf;
    bf16_t* gbuf;
    bf16_t* cbuf;
    bf16_t* kbuf;
    bf16_t* vT;
};

DI unsigned pk2(float a, float b) { f32x2 v = {a, b}; bf16v2 r = __builtin_convertvector(v, bf16v2); return __builtin_bit_cast(unsigned, r); }
DI float bf_lo(unsigned u) { return __uint_as_float(u << 16); }
DI float bf_hi(unsigned u) { return __uint_as_float(u & 0xffff0000u); }
DI float silu_f(float x) { return x / (1.f + __expf(-x)); }
DI float sigmoid_f(float x) { return 1.f / (1.f + __expf(-x)); }
DI int otid() { int t = threadIdx.x; asm volatile("" : "+v"(t)); return t; }
#define MFMA32(a, b, c) __builtin_amdgcn_mfma_f32_32x32x16_bf16((a), (b), (c), 0, 0, 0)

DI const float* res_in_row(const Params& p, int layer, int r) {
    const int b = r / TB, t = r - b * TB;
    if (t < CTX) return (layer == 0 ? p.ctx : (const float*)p.xctx) + (size_t)(b * CTX + t) * DM;
    return (layer == 0 ? p.x : (const float*)p.out) + (size_t)(b * SEQ + t - CTX) * DM;
}
DI float* res_out_row(const Params& p, int r) {
    const int b = r / TB, t = r - b * TB;
    if (t < CTX) return p.xctx + (size_t)(b * CTX + t) * DM;
    return p.out + (size_t)(b * SEQ + t - CTX) * DM;
}

#define XB_TMO      128
#define XB_XCNT(j)  (256  + 64 * (j))
#define XB_XSUB(j)  (1280 + 64 * (j))
#define XB_XGEN(j)  (2304 + 64 * (j))
#define XB_TOP      3328
#define XB_TOPGEN   3392
#define XCD_BAR_WORDS 3456
#define XB_SPIN_CAP (1u << 22)
DI unsigned xb_ld(unsigned* p) { return __hip_atomic_load(p, __ATOMIC_RELAXED, __HIP_MEMORY_SCOPE_AGENT); }
DI unsigned xb_add(unsigned* p, unsigned v) { return __hip_atomic_fetch_add(p, v, __ATOMIC_RELAXED, __HIP_MEMORY_SCOPE_AGENT); }
DI unsigned xb_xcc_id() { return (unsigned)__builtin_amdgcn_s_getreg((3 << 11) | 20) & 0xFu; }
#define XB_SPIN(cond, bar) do { unsigned _sp = 0; while (cond) { __builtin_amdgcn_s_sleep(1); \
    if ((++_sp & 255u) == 0u) { if (xb_ld(&(bar)[XB_TMO])) break; if (_sp > XB_SPIN_CAP) { atomicAdd(&(bar)[XB_TMO], 1u); break; } } } } while (0)
struct XcdBarrier { unsigned* bar; unsigned x; volatile LAS unsigned* st; };
DI XcdBarrier xcd_barrier_post(unsigned* bar, volatile LAS unsigned* st) {
    XcdBarrier b; b.bar = bar; b.x = xb_xcc_id(); b.st = st;
    if (threadIdx.x == 0) (void)xb_add(&bar[XB_XCNT(b.x)], 1u);
    return b;
}
DI void xcd_barrier_complete(unsigned* bar, unsigned x, unsigned& nloc, unsigned& nx) {
    const unsigned G = gridDim.x * gridDim.y * gridDim.z;
    unsigned sum, cnt, mine, sp = 0u;
    for (;;) {
        sum = 0u; cnt = 0u; mine = 0u;
#pragma unroll
        for (unsigned j = 0; j < 16; ++j) { const unsigned c = xb_ld(&bar[XB_XCNT(j)]); sum += c; cnt += (c > 0u) ? 1u : 0u; mine = (j == x) ? c : mine; }
        if (sum == G) break;
        __builtin_amdgcn_s_sleep(1);
        if ((++sp & 255u) == 0u) { if (xb_ld(&bar[XB_TMO])) break; if (sp > XB_SPIN_CAP) { atomicAdd(&bar[XB_TMO], 1u); break; } }
    }
    nloc = mine > 0u ? mine : 1u; nx = cnt > 0u ? cnt : 1u;
}
DI void xcd_barrier(const XcdBarrier& b) {
    asm volatile("s_waitcnt vmcnt(0)" ::: "memory");
    __syncthreads();
    if (threadIdx.x == 0) {
        unsigned* bar = b.bar;
        __builtin_amdgcn_s_waitcnt(0);
        unsigned nloc = b.st[0], nx = b.st[1];
        if (nloc == 0u) { xcd_barrier_complete(bar, b.x, nloc, nx); b.st[0] = nloc; b.st[1] = nx; }
        const unsigned old = xb_add(&bar[XB_XSUB(b.x)], 1u);
        const unsigned gen = old / nloc;
        if (old + 1u == (gen + 1u) * nloc) {
            __builtin_amdgcn_fence(__ATOMIC_RELEASE, "agent");
            asm volatile("s_waitcnt vmcnt(0)" ::: "memory");
            const unsigned og = xb_add(&bar[XB_TOP], 1u);
            const unsigned tg = og / nx;
            if (og + 1u == (tg + 1u) * nx) xb_add(&bar[XB_TOPGEN], 1u);
            else XB_SPIN(xb_ld(&bar[XB_TOPGEN]) == tg, bar);
            __builtin_amdgcn_fence(__ATOMIC_ACQUIRE, "agent");
            xb_add(&bar[XB_XGEN(b.x)], 1u);
            asm volatile("s_waitcnt vmcnt(0)" ::: "memory");
        } else {
            XB_SPIN(xb_ld(&bar[XB_XGEN(b.x)]) == gen, bar);
            __builtin_amdgcn_fence(__ATOMIC_ACQUIRE, "agent");
            asm volatile("s_waitcnt vmcnt(0)" ::: "memory");
        }
    }
    __syncthreads();
}

DI void mod_item(const Params& p, char* lds, int item) {
    const int tid = otid();
    const int layer = item / 48, n0 = (item % 48) * 64;
    float* sc = (float*)lds;
    float* part = (float*)(lds + 36864);
    __syncthreads();
    for (int i = tid; i < 9 * 1024; i += 256) { const int j = i >> 10, k = i & 1023; const float v = (j < 8) ? p.c[j * 1024 + k] : p.c_ctx[k]; sc[i] = silu_f(v); }
    __syncthreads();
    const int kg = tid >> 6, cl = tid & 63;
    float acc[9];
#pragma unroll
    for (int j = 0; j < 9; ++j) acc[j] = 0.f;
    const float* wp = p.mod_w + ((size_t)layer * 1024 + kg * 256) * 3072 + n0 + cl;
    const float* scp = sc + kg * 256;
#pragma unroll 8
    for (int k = 0; k < 256; ++k) {
        const float wv = wp[(size_t)k * 3072];
#pragma unroll
        for (int j = 0; j < 9; ++j) acc[j] += scp[j * 1024 + k] * wv;
    }
#pragma unroll
    for (int j = 0; j < 9; ++j) part[(kg * 9 + j) * 64 + cl] = acc[j];
    __syncthreads();
    for (int i = tid; i < 9 * 64; i += 256) {
        const int j = i >> 6, cc = i & 63;
        float s = p.mod_b[layer * 3072 + n0 + cc];
#pragma unroll
        for (int g = 0; g < 4; ++g) s += part[(g * 9 + j) * 64 + cc];
        p.mvec[((size_t)layer * 9 + j) * 3072 + n0 + cc] = s;
    }
}

DI void rope_item(const Params& p, int item) {
    const int idx = item * 256 + otid();
    const int t = idx >> 5, pp = idx & 31;
    const float pos = (float)((pp < 16) ? (t >> 6) : (t & 63));
    const float freq = powf(10000.0f, -(float)(pp & 15) / 16.0f);
    const float ang = pos * freq;
    float sn, cs; sincosf(ang, &sn, &cs);
    *(f32x2*)(p.rope + (size_t)idx * 2) = (f32x2){cs, sn};
}

DI void wconv_item(const float* __restrict__ W, bf16_t* __restrict__ Wt, int N, int tile, char* lds) {
    const int tid = otid();
    const int ntn = N >> 6, kt = tile / ntn, nt_ = tile - kt * ntn, k0 = kt * 64, n0 = nt_ * 64;
    float* tl = (float*)lds;
    __syncthreads();
#pragma unroll
    for (int j = 0; j < 4; ++j) {
        const int kk = (tid >> 4) + 16 * j, nn = (tid & 15) * 4;
        const f32x4 v = *(const f32x4*)(W + (size_t)(k0 + kk) * N + n0 + nn);
        tl[kk * 65 + nn + 0] = v[0]; tl[kk * 65 + nn + 1] = v[1]; tl[kk * 65 + nn + 2] = v[2]; tl[kk * 65 + nn + 3] = v[3];
    }
    __syncthreads();
#pragma unroll
    for (int j = 0; j < 2; ++j) {
        const int idx = tid + 256 * j, n = idx >> 3, kc = (idx & 7) * 8;
        u32x4 o;
        o[0] = pk2(tl[(kc + 0) * 65 + n], tl[(kc + 1) * 65 + n]);
        o[1] = pk2(tl[(kc + 2) * 65 + n], tl[(kc + 3) * 65 + n]);
        o[2] = pk2(tl[(kc + 4) * 65 + n], tl[(kc + 5) * 65 + n]);
        o[3] = pk2(tl[(kc + 6) * 65 + n], tl[(kc + 7) * 65 + n]);
        *(u32x4*)(Wt + (size_t)(n0 + n) * 1024 + k0 + kc) = o;
    }
}

DI void phase0(const Params& p, char* lds) {
    const int total = 192 + 256 + 4096;
    for (int item = blockIdx.x; item < total; item += gridDim.x) {
        if (item < 192) mod_item(p, lds, item);
        else if (item < 448) rope_item(p, item - 192);
        else {
            int w = item - 448; const int j = w >> 11; w &= 2047;
            if (w < 640) wconv_item(p.ev_w_in + (size_t)j * 1024 * 2560, p.wt_ev_in + (size_t)j * 2560 * 1024, 2560, w, lds);
            else if (w < 896) wconv_item(p.ev_w_out + (size_t)j * 1024 * 1024, p.wt_ev_out + (size_t)j * 1024 * 1024, 1024, w - 640, lds);
            else if (w < 1792) wconv_item(p.od_w_in + (size_t)j * 1024 * 3584, p.wt_od_in + (size_t)j * 3584 * 1024, 3584, w - 896, lds);
            else wconv_item(p.od_w_out + (size_t)j * 1024 * 1024, p.wt_od_out + (size_t)j * 1024 * 1024, 1024, w - 1792, lds);
        }
    }
}

DI void norm_phase(const Params& p, int layer) {
    const int lane = otid() & 63, w = otid() >> 6;
    const float* g = p.norm_g + layer * 1024;
    for (int item = blockIdx.x; item < MROWS / 4; item += gridDim.x) {
        const int r = item * 4 + w;
        const int b = r / TB, t = r - b * TB;
        const int cond = (t < CTX) ? 8 : b;
        const float* xr = res_in_row(p, layer, r);
        const float* mv = p.mvec + ((size_t)layer * 9 + cond) * 3072;
        f32x4 v[4]; float ss = 0.f;
#pragma unroll
        for (int j = 0; j < 4; ++j) { v[j] = *(const f32x4*)(xr + lane * 4 + 256 * j); ss += v[j][0] * v[j][0] + v[j][1] * v[j][1] + v[j][2] * v[j][2] + v[j][3] * v[j][3]; }
#pragma unroll
        for (int o = 32; o >= 1; o >>= 1) ss += __shfl_xor(ss, o);
        const float rstd = rsqrtf(ss * (1.0f / 1024.0f) + EPS);
        bf16_t* hr = p.h + (size_t)r * 1024;
#pragma unroll
        for (int j = 0; j < 4; ++j) {
            const int c0 = lane * 4 + 256 * j;
            const f32x4 gg = *(const f32x4*)(g + c0), sh = *(const f32x4*)(mv + c0), sc = *(const f32x4*)(mv + 1024 + c0);
            float y[4];
#pragma unroll
            for (int e = 0; e < 4; ++e) y[e] = (v[j][e] * rstd * gg[e]) * (1.f + sc[e]) + sh[e];
            *(u32x2*)(hr + c0) = (u32x2){pk2(y[0], y[1]), pk2(y[2], y[3])};
        }
    }
}

DI void final_phase(const Params& p) {
    const int lane = otid() & 63, w = otid() >> 6;
    for (int item = blockIdx.x; item < NB * SEQ / 4; item += gridDim.x) {
        const int r = item * 4 + w;
        float* xr = p.out + (size_t)r * 1024;
        f32x4 v[4]; float ss = 0.f;
#pragma unroll
        for (int j = 0; j < 4; ++j) { v[j] = *(const f32x4*)(xr + lane * 4 + 256 * j); ss += v[j][0] * v[j][0] + v[j][1] * v[j][1] + v[j][2] * v[j][2] + v[j][3] * v[j][3]; }
#pragma unroll
        for (int o = 32; o >= 1; o >>= 1) ss += __shfl_xor(ss, o);
        const float rstd = rsqrtf(ss * (1.0f / 1024.0f) + EPS);
#pragma unroll
        for (int j = 0; j < 4; ++j) {
            const int c0 = lane * 4 + 256 * j;
            const f32x4 gg = *(const f32x4*)(p.final_g + c0);
            f32x4 o; for (int e = 0; e < 4; ++e) o[e] = v[j][e] * rstd * gg[e];
            *(f32x4*)(xr + c0) = o;
        }
    }
}

template <bool SWAP>
DI void gemm_mainloop(const bf16_t* __restrict__ A, const bf16_t* __restrict__ W, int row0, int col0, f32x16 (&acc)[2][2], char* lds) {
    const int tid = otid(), lane = tid & 63, w = __builtin_amdgcn_readfirstlane(tid >> 6), wm = w >> 1, wn = w & 1, l31 = lane & 31, hh = lane >> 5;
    const bf16_t* ap = A + (size_t)(row0 + (tid >> 3)) * 1024 + (tid & 7) * 8;
    const bf16_t* bp = W + (size_t)(col0 + (tid >> 3)) * 1024 + (tid & 7) * 8;
    char* sa = lds + (tid >> 3) * LROW + (tid & 7) * 16;
    char* sb = sa + GT_BYTES;
    const char* fa = lds + (wm * 64 + l31) * LROW + hh * 16;
    const char* fb = lds + GT_BYTES + (wn * 64 + l31) * LROW + hh * 16;
    u32x4 ra[4], rb[4];
#pragma unroll
    for (int j = 0; j < 4; ++j) { ra[j] = *(const u32x4*)(ap + (size_t)j * 32 * 1024); rb[j] = *(const u32x4*)(bp + (size_t)j * 32 * 1024); }
#pragma unroll
    for (int i = 0; i < 2; ++i)
#pragma unroll
        for (int j = 0; j < 2; ++j)
#pragma unroll
            for (int e = 0; e < 16; ++e) acc[i][j][e] = 0.f;
#pragma unroll 1
    for (int kt = 0; kt < 16; ++kt) {
        __syncthreads();
#pragma unroll
        for (int j = 0; j < 4; ++j) { *(u32x4*)(sa + j * 32 * LROW) = ra[j]; *(u32x4*)(sb + j * 32 * LROW) = rb[j]; }
        __syncthreads();
        if (kt + 1 < 16) {
            const int ko = (kt + 1) * 64;
#pragma unroll
            for (int j = 0; j < 4; ++j) { ra[j] = *(const u32x4*)(ap + (size_t)j * 32 * 1024 + ko); rb[j] = *(const u32x4*)(bp + (size_t)j * 32 * 1024 + ko); }
        }
#pragma unroll
        for (int ks = 0; ks < 4; ++ks) {
            bf16x8 af[2], bf[2];
#pragma unroll
            for (int i = 0; i < 2; ++i) { af[i] = *(const bf16x8*)(fa + i * 32 * LROW + ks * 32); bf[i] = *(const bf16x8*)(fb + i * 32 * LROW + ks * 32); }
#pragma unroll
            for (int i = 0; i < 2; ++i)
#pragma unroll
                for (int j = 0; j < 2; ++j) {
                    if (SWAP) acc[i][j] = MFMA32(af[i], bf[j], acc[i][j]);
                    else      acc[j][i] = MFMA32(bf[j], af[i], acc[j][i]);
                }
        }
    }
}

template <int TR>
DI void epi_plain(const f32x16 (&acc)[2][2], bf16_t* dst, int stride, int row0) {
    const int lane = otid() & 63, w = __builtin_amdgcn_readfirstlane(otid() >> 6), wm = w >> 1, l31 = lane & 31, hh = lane >> 5;
#pragma unroll
    for (int ti = 0; ti < 2; ++ti) {
        const int r = row0 + wm * 64 + 32 * ti + l31;
        bf16_t* rp = dst + (size_t)r * stride;
#pragma unroll
        for (int fi = 0; fi < 2; ++fi)
#pragma unroll
            for (int g = 0; g < 4; ++g) {
                float v[4];
#pragma unroll
                for (int e = 0; e < 4; ++e) { float x = acc[fi][ti][4 * g + e]; if (TR == 1) x = silu_f(x); if (TR == 2) x *= 0.125f; v[e] = x; }
                *(u32x2*)(rp + 32 * fi + 8 * g + 4 * hh) = (u32x2){pk2(v[0], v[1]), pk2(v[2], v[3])};
            }
    }
}

template <bool RMS, bool ISQ>
DI void epi_qk(const Params& p, const f32x16 (&acc)[2][2], const float* gain, int row0, bf16_t* qdst  , int kslot, int nkv) {
    const int lane = otid() & 63, w = __builtin_amdgcn_readfirstlane(otid() >> 6), wm = w >> 1, l31 = lane & 31, hh = lane >> 5;
#pragma unroll
    for (int ti = 0; ti < 2; ++ti) {
        const int r = row0 + wm * 64 + 32 * ti + l31;
        const int b = r / TB, t = r - b * TB;
        float v[2][16];
#pragma unroll
        for (int fi = 0; fi < 2; ++fi)
#pragma unroll
            for (int e = 0; e < 16; ++e) v[fi][e] = acc[fi][ti][e];
        if (RMS) {
            float ss = 0.f;
#pragma unroll
            for (int fi = 0; fi < 2; ++fi)
#pragma unroll
                for (int e = 0; e < 16; ++e) ss += v[fi][e] * v[fi][e];
            ss += __shfl_xor(ss, 32);
            const float rstd = rsqrtf(ss * (1.0f / 64.0f) + EPS);
#pragma unroll
            for (int fi = 0; fi < 2; ++fi)
#pragma unroll
                for (int g = 0; g < 4; ++g) {
                    const f32x4 gg = *(const f32x4*)(gain + 32 * fi + 8 * g + 4 * hh);
#pragma unroll
                    for (int e = 0; e < 4; ++e) v[fi][4 * g + e] = v[fi][4 * g + e] * rstd * gg[e];
                }
        }
        if (t >= CTX) {
            const float* rt = p.rope + (size_t)(t - CTX) * 64;
#pragma unroll
            for (int fi = 0; fi < 2; ++fi)
#pragma unroll
                for (int g = 0; g < 4; ++g) {
                    const f32x4 cs = *(const f32x4*)(rt + (16 * fi + 4 * g + 2 * hh) * 2);
                    const float x0 = v[fi][4 * g + 0], x1 = v[fi][4 * g + 1], x2 = v[fi][4 * g + 2], x3 = v[fi][4 * g + 3];
                    v[fi][4 * g + 0] = x0 * cs[0] - x1 * cs[1];
                    v[fi][4 * g + 1] = x0 * cs[1] + x1 * cs[0];
                    v[fi][4 * g + 2] = x2 * cs[2] - x3 * cs[3];
                    v[fi][4 * g + 3] = x2 * cs[3] + x3 * cs[2];
                }
        }
        bf16_t* rp = ISQ ? (qdst + (size_t)r * 1024) : (p.kbuf + ((size_t)(b * nkv + kslot) * TB + t) * 64);
#pragma unroll
        for (int fi = 0; fi < 2; ++fi)
#pragma unroll
            for (int g = 0; g < 4; ++g) {
                float o[4];
#pragma unroll
                for (int e = 0; e < 4; ++e) o[e] = ISQ ? v[fi][4 * g + e] * 0.125f : v[fi][4 * g + e];
                *(u32x2*)(rp + 32 * fi + 8 * g + 4 * hh) = (u32x2){pk2(o[0], o[1]), pk2(o[2], o[3])};
            }
    }
}

DI void epi_k_plain(const Params& p, const f32x16 (&acc)[2][2], int row0, int kslot, int nkv) {
    const int lane = otid() & 63, w = __builtin_amdgcn_readfirstlane(otid() >> 6), wm = w >> 1, l31 = lane & 31, hh = lane >> 5;
#pragma unroll
    for (int ti = 0; ti < 2; ++ti) {
        const int r = row0 + wm * 64 + 32 * ti + l31;
        const int b = r / TB, t = r - b * TB;
        bf16_t* rp = p.kbuf + ((size_t)(b * nkv + kslot) * TB + t) * 64;
#pragma unroll
        for (int fi = 0; fi < 2; ++fi)
#pragma unroll
            for (int g = 0; g < 4; ++g)
                *(u32x2*)(rp + 32 * fi + 8 * g + 4 * hh) = (u32x2){pk2(acc[fi][ti][4 * g], acc[fi][ti][4 * g + 1]), pk2(acc[fi][ti][4 * g + 2], acc[fi][ti][4 * g + 3])};
    }
}

DI void epi_v(const Params& p, const f32x16 (&acc)[2][2], int row0, int vslot, int nkv) {
    const int lane = otid() & 63, w = __builtin_amdgcn_readfirstlane(otid() >> 6), wm = w >> 1, l31 = lane & 31, hh = lane >> 5;
#pragma unroll
    for (int ti = 0; ti < 2; ++ti) {
        const int rb = row0 + wm * 64 + 32 * ti;
        const int b = rb / TB, tb = rb - b * TB;
#pragma unroll
        for (int fi = 0; fi < 2; ++fi) {
            const int d = 32 * fi + l31;
            bf16_t* vp = p.vT + ((size_t)(b * nkv + vslot) * 64 + d) * TB + tb;
#pragma unroll
            for (int gq = 0; gq < 2; ++gq) {
                u32x4 o;
                o[0] = pk2(acc[ti][fi][8 * gq + 0], acc[ti][fi][8 * gq + 1]);
                o[1] = pk2(acc[ti][fi][8 * gq + 2], acc[ti][fi][8 * gq + 3]);
                o[2] = pk2(acc[ti][fi][8 * gq + 4], acc[ti][fi][8 * gq + 5]);
                o[3] = pk2(acc[ti][fi][8 * gq + 6], acc[ti][fi][8 * gq + 7]);
                *(u32x4*)(vp + 16 * gq + 8 * hh) = o;
            }
        }
    }
}

DI void gemm_in_phase(const Params& p, int layer, char* lds) {
    const bool even = (layer & 1) == 0;
    const int j = layer >> 1;
    const int N = even ? 2560 : 3584, nct = N / 128;
    const bf16_t* W = even ? p.wt_ev_in + (size_t)j * 2560 * 1024 : p.wt_od_in + (size_t)j * 3584 * 1024;
    const bool last = (layer == 3);
    const int xcd = blockIdx.x & 7, local = blockIdx.x >> 3, nlocal = gridDim.x >> 3;
    const int wn = __builtin_amdgcn_readfirstlane(otid() >> 6) & 1;
    for (int li = local; li < 18 * nct; li += nlocal) {
        const int rt = xcd + 8 * (li / nct), ct = li % nct;
        const int row0 = rt * 128, col0 = ct * 128;
        const bool ctxrows = (rt % 18) < 2;
        if (last && ctxrows && (col0 < 2048 || col0 >= 3072)) continue;
        const int c64 = col0 + wn * 64;
        f32x16 acc[2][2];
        if (even) {
            if (col0 == 640 || col0 == 1920) {
                gemm_mainloop<true>(p.h, W, row0, col0, acc, lds);
                epi_v(p, acc, row0, (col0 == 640 ? 0 : 2) + wn, 4);
            } else {
                gemm_mainloop<false>(p.h, W, row0, col0, acc, lds);
                if (col0 < 512) epi_qk<true, true>(p, acc, p.a_q_gain + j * 64, row0, p.qbuf + c64, 0, 4);
                else if (col0 < 640) epi_qk<true, false>(p, acc, p.a_k_gain + j * 64, row0, nullptr, wn, 4);
                else if (col0 < 1280) epi_plain<1>(acc, p.gbuf + (c64 - 768), 1024, row0);
                else if (col0 < 1792) epi_qk<false, true>(p, acc, nullptr, row0, p.qbuf + 512 + (c64 - 1280), 0, 4);
                else if (col0 < 1920) epi_qk<false, false>(p, acc, nullptr, row0, nullptr, 2 + wn, 4);
                else epi_plain<1>(acc, p.gbuf + 512 + (c64 - 2048), 1024, row0);
            }
        } else {
            if (col0 >= 2560 && col0 < 3072) {
                gemm_mainloop<true>(p.h, W, row0, col0, acc, lds);
                epi_v(p, acc, row0, (c64 - 2560) >> 6, 8);
            } else {
                gemm_mainloop<false>(p.h, W, row0, col0, acc, lds);
                if (col0 < 1024) epi_plain<0>(acc, p.cbuf + c64, 1536, row0);
                else if (col0 < 1536) epi_plain<1>(acc, p.cbuf + c64, 1536, row0);
                else if (col0 < 2048) epi_plain<2>(acc, p.qbuf + (c64 - 1536), 512, row0);
                else if (col0 < 2560) epi_k_plain(p, acc, row0, (c64 - 2048) >> 6, 8);
                else epi_plain<1>(acc, p.gbuf + (c64 - 3072), 512, row0);
            }
        }
    }
}

DI void gemm_out_phase(const Params& p, int layer, char* lds) {
    const bool even = (layer & 1) == 0;
    const int j = layer >> 1;
    const bf16_t* W = (even ? p.wt_ev_out : p.wt_od_out) + (size_t)j * 1024 * 1024;
    const bool last = (layer == 3);
    const int xcd = blockIdx.x & 7, local = blockIdx.x >> 3, nlocal = gridDim.x >> 3;
    const int lane = otid() & 63, w = __builtin_amdgcn_readfirstlane(otid() >> 6), wm = w >> 1, wn = w & 1, l31 = lane & 31, hh = lane >> 5;
    for (int li = local; li < 18 * 8; li += nlocal) {
        const int rt = xcd + 8 * (li >> 3), ct = li & 7;
        const int row0 = rt * 128, col0 = ct * 128;
        if (last && (rt % 18) < 2) continue;
        f32x16 acc[2][2];
        gemm_mainloop<false>(p.h  , W, row0, col0, acc, lds);
#pragma unroll
        for (int ti = 0; ti < 2; ++ti) {
            const int r = row0 + wm * 64 + 32 * ti + l31;
            const int b = r / TB, t = r - b * TB;
            const int cond = (t < CTX) ? 8 : b;
            const float* gm = p.mvec + ((size_t)layer * 9 + cond) * 3072 + 2048;
            const float* xi = res_in_row(p, layer, r);
            float* xo = res_out_row(p, r);
#pragma unroll
            for (int fi = 0; fi < 2; ++fi)
#pragma unroll
                for (int g = 0; g < 4; ++g) {
                    const int c = col0 + wn * 64 + 32 * fi + 8 * g + 4 * hh;
                    const f32x4 xv = *(const f32x4*)(xi + c), gv = *(const f32x4*)(gm + c);
                    f32x4 o;
#pragma unroll
                    for (int e = 0; e < 4; ++e) o[e] = xv[e] + gv[e] * acc[fi][ti][4 * g + e];
                    *(f32x4*)(xo + c) = o;
                }
        }
    }
}

template <int MODE>
DI void attn_block(char* lds, const bf16_t* __restrict__ Kb, const bf16_t* __restrict__ Vb, int nt, int lat_lo,
                   const bf16_t* __restrict__ qptr, int qstride, const bf16_t* __restrict__ gptr, int gstride, bf16_t* __restrict__ optr,
                   float sink_l2, int tq_base, const float* rpb_lds, int rq) {
    const int tid = otid(), lane = tid & 63, l31 = lane & 31, hh = lane >> 5;
    char* ldsK = lds; char* ldsV = lds + 64 * LROW;
    bf16x8 qf[4];
#pragma unroll
    for (int ks = 0; ks < 4; ++ks) qf[ks] = *(const bf16x8*)(qptr + (size_t)l31 * qstride + 16 * ks + 8 * hh);
    f32x16 O0, O1;
#pragma unroll
    for (int e = 0; e < 16; ++e) { O0[e] = 0.f; O1[e] = 0.f; }
    float mrun = (MODE == 1) ? sink_l2 : -1e30f;
    float lrun = (MODE == 1 && hh == 0) ? 1.f : 0.f;
    const int srow0 = tid >> 3, sch = tid & 7;
    u32x4 kr[2], vr[2];
    {
        const int t0 = 0;
#pragma unroll
        for (int j = 0; j < 2; ++j) {
            kr[j] = *(const u32x4*)(Kb + (size_t)(t0 + srow0 + 32 * j) * 64 + sch * 8);
            vr[j] = *(const u32x4*)(Vb + (size_t)(srow0 + 32 * j) * TB + t0 + sch * 8);
        }
    }
    const int tq = tq_base + l31;
    int cq = 0, cs_ = 0, rs = 0;
    if (MODE == 2) { cq = tq & 63; cs_ = min(max(cq - 8, 0), 48); rs = min(max(rq - 4, 0), 24); }
#pragma unroll 1
    for (int it = 0; it < nt; ++it) {
        __syncthreads();
        if (MODE == 2 && it > 0) {
            const int t0 = (it < 4) ? it * 64 : CTX + lat_lo + (it - 4) * 64;
#pragma unroll
            for (int j = 0; j < 2; ++j) {
                kr[j] = *(const u32x4*)(Kb + (size_t)(t0 + srow0 + 32 * j) * 64 + sch * 8);
                vr[j] = *(const u32x4*)(Vb + (size_t)(srow0 + 32 * j) * TB + t0 + sch * 8);
            }
        }
#pragma unroll
        for (int j = 0; j < 2; ++j) {
            *(u32x4*)(ldsK + (srow0 + 32 * j) * LROW + sch * 16) = kr[j];
            *(u32x4*)(ldsV + (srow0 + 32 * j) * LROW + sch * 16) = vr[j];
        }
        __syncthreads();
        if (MODE != 2 && it + 1 < nt) {
            const int t0 = (it + 1 < 4) ? (it + 1) * 64 : CTX + lat_lo + (it + 1 - 4) * 64;
#pragma unroll
            for (int j = 0; j < 2; ++j) {
                kr[j] = *(const u32x4*)(Kb + (size_t)(t0 + srow0 + 32 * j) * 64 + sch * 8);
                vr[j] = *(const u32x4*)(Vb + (size_t)(srow0 + 32 * j) * TB + t0 + sch * 8);
            }
        }
        bool active = true;
        int krow = 0;
        if (MODE == 2 && it >= 4) { krow = (lat_lo >> 6) + it - 4; active = (krow >= rs) && (krow < rs + 8); }
        if (active) {
            f32x16 s0, s1;
#pragma unroll
            for (int e = 0; e < 16; ++e) { s0[e] = 0.f; s1[e] = 0.f; }
#pragma unroll
            for (int ks = 0; ks < 4; ++ks) {
                const bf16x8 k0 = *(const bf16x8*)(ldsK + l31 * LROW + ks * 32 + hh * 16);
                const bf16x8 k1 = *(const bf16x8*)(ldsK + (32 + l31) * LROW + ks * 32 + hh * 16);
                s0 = MFMA32(k0, qf[ks], s0);
                s1 = MFMA32(k1, qf[ks], s1);
            }
            __builtin_amdgcn_sched_barrier(0);
            if (MODE == 1 && it >= 4) {
                const int base = lat_lo + (it - 4) * 64 + 4 * hh - tq + 128;
#pragma unroll
                for (int e = 0; e < 16; ++e) {
                    const int o = (e >> 2) * 8 + (e & 3);
                    s0[e] = ((unsigned)(base + o) <= 256u) ? s0[e] * LOG2E : -1e30f;
                    s1[e] = ((unsigned)(base + 32 + o) <= 256u) ? s1[e] * LOG2E : -1e30f;
                }
            } else if (MODE == 2 && it >= 4) {
                const float* rp = rpb_lds + (krow - rq + 7) * 31;
                const int cb = 4 * hh - cq + 15;
#pragma unroll
                for (int e = 0; e < 16; ++e) {
                    const int kc0 = (e >> 2) * 8 + (e & 3) + 4 * hh, kc1 = kc0 + 32;
                    const int i0 = min(max(kc0 - cq + 15, 0), 30), i1 = min(max(kc1 - cq + 15, 0), 30);
                    const float b0 = rp[i0], b1 = rp[i1];
                    s0[e] = ((unsigned)(kc0 - cs_) < 16u) ? (s0[e] + b0) * LOG2E : -1e30f;
                    s1[e] = ((unsigned)(kc1 - cs_) < 16u) ? (s1[e] + b1) * LOG2E : -1e30f;
                }
                (void)cb;
            } else {
#pragma unroll
                for (int e = 0; e < 16; ++e) { s0[e] *= LOG2E; s1[e] *= LOG2E; }
            }
            float mx = -1e30f;
#pragma unroll
            for (int e = 0; e < 16; ++e) mx = fmaxf(mx, fmaxf(s0[e], s1[e]));
            mx = fmaxf(mx, __shfl_xor(mx, 32));
            const float mnew = fmaxf(mrun, mx);
            const float alpha = __builtin_amdgcn_exp2f(mrun - mnew);
            mrun = mnew;
            float ps = 0.f;
#pragma unroll
            for (int e = 0; e < 16; ++e) { s0[e] = __builtin_amdgcn_exp2f(s0[e] - mnew); s1[e] = __builtin_amdgcn_exp2f(s1[e] - mnew); ps += s0[e] + s1[e]; }
            lrun = lrun * alpha + ps;
#pragma unroll
            for (int e = 0; e < 16; ++e) { O0[e] *= alpha; O1[e] *= alpha; }
            bf16x8 pf[2][2];
            __builtin_amdgcn_sched_barrier(0);
#pragma unroll
            for (int s = 0; s < 2; ++s) {
                u32x4 a, b;
                a[0] = pk2(s0[8 * s + 0], s0[8 * s + 1]); a[1] = pk2(s0[8 * s + 2], s0[8 * s + 3]); a[2] = pk2(s0[8 * s + 4], s0[8 * s + 5]); a[3] = pk2(s0[8 * s + 6], s0[8 * s + 7]);
                b[0] = pk2(s1[8 * s + 0], s1[8 * s + 1]); b[1] = pk2(s1[8 * s + 2], s1[8 * s + 3]); b[2] = pk2(s1[8 * s + 4], s1[8 * s + 5]); b[3] = pk2(s1[8 * s + 6], s1[8 * s + 7]);
                pf[0][s] = __builtin_bit_cast(bf16x8, a); pf[1][s] = __builtin_bit_cast(bf16x8, b);
            }
#pragma unroll
            for (int sub = 0; sub < 2; ++sub)
#pragma unroll
                for (int s = 0; s < 2; ++s) {
                    const bf16x8 v0 = *(const bf16x8*)(ldsV + l31 * LROW + (32 * sub + 16 * s + 8 * hh) * 2);
                    const bf16x8 v1 = *(const bf16x8*)(ldsV + (32 + l31) * LROW + (32 * sub + 16 * s + 8 * hh) * 2);
                    O0 = MFMA32(v0, pf[sub][s], O0);
                    O1 = MFMA32(v1, pf[sub][s], O1);
                }
            __builtin_amdgcn_sched_barrier(0);
        }
    }
    const float ltot = lrun + __shfl_xor(lrun, 32);
    const float inv = 1.0f / ltot;
    const bf16_t* gp = gptr + (size_t)l31 * gstride;
    bf16_t* op = optr + (size_t)l31 * 1024;
#pragma unroll
    for (int g = 0; g < 4; ++g) {
        {
            const int d = 8 * g + 4 * hh;
            const u32x2 gg = *(const u32x2*)(gp + d);
            const float o0 = O0[4 * g] * inv * bf_lo(gg[0]), o1 = O0[4 * g + 1] * inv * bf_hi(gg[0]), o2 = O0[4 * g + 2] * inv * bf_lo(gg[1]), o3 = O0[4 * g + 3] * inv * bf_hi(gg[1]);
            *(u32x2*)(op + d) = (u32x2){pk2(o0, o1), pk2(o2, o3)};
        }
        {
            const int d = 32 + 8 * g + 4 * hh;
            const u32x2 gg = *(const u32x2*)(gp + d);
            const float o0 = O1[4 * g] * inv * bf_lo(gg[0]), o1 = O1[4 * g + 1] * inv * bf_hi(gg[0]), o2 = O1[4 * g + 2] * inv * bf_lo(gg[1]), o3 = O1[4 * g + 3] * inv * bf_hi(gg[1]);
            *(u32x2*)(op + d) = (u32x2){pk2(o0, o1), pk2(o2, o3)};
        }
    }
}

DI void even_mix_phase(const Params& p, int layer, char* lds) {
    const int j = layer >> 1;
    const bool upd = layer < 3;
    const int w = __builtin_amdgcn_readfirstlane(otid() >> 6);
    const int total = 2048 + (upd ? 256 : 0);
    for (int item = blockIdx.x; item < total; item += gridDim.x) {
        if (item < 2048) {
            const bool isB = item >= 1024;
            const int it2 = item & 1023;
            const int b = it2 >> 7, kvh = (it2 >> 6) & 1, qt = it2 & 63;
            const int slot = (isB ? 2 : 0) + kvh;
            const int head = kvh * 4 + w;
            const int col = (isB ? 512 : 0) + head * 64;
            const int r0 = b * TB + CTX + qt * 32;
            const bf16_t* Kb = p.kbuf + (size_t)(b * 4 + slot) * TB * 64;
            const bf16_t* Vb = p.vT + (size_t)(b * 4 + slot) * 64 * TB;
            const bf16_t* qp = p.qbuf + (size_t)r0 * 1024 + col;
            const bf16_t* gp = p.gbuf + (size_t)r0 * 1024 + col;
            bf16_t* op = p.h + (size_t)r0 * 1024 + col;
            if (!isB) attn_block<0>(lds, Kb, Vb, 36, 0, qp, 1024, gp, 1024, op, 0.f, qt * 32, nullptr, 0);
            else {
                const int q0 = qt * 32;
                const int lo = max(0, q0 - 128) & ~63;
                const int hi = (min(SEQ, q0 + 160) + 63) & ~63;
                attn_block<1>(lds, Kb, Vb, 4 + ((hi - lo) >> 6), lo, qp, 1024, gp, 1024, op, p.b_sink[j * 8 + head] * LOG2E, q0, nullptr, 0);
            }
        } else {
            const int idx = item - 2048;
            const int b = idx >> 5, slot = (idx >> 3) & 3, qt = idx & 7;
            const bool isB = slot >= 2;
            const int head = (slot & 1) * 4 + w;
            const int col = (isB ? 512 : 0) + head * 64;
            const int r0 = b * TB + qt * 32;
            const bf16_t* Kb = p.kbuf + (size_t)(b * 4 + slot) * TB * 64;
            const bf16_t* Vb = p.vT + (size_t)(b * 4 + slot) * 64 * TB;
            const bf16_t* qp = p.qbuf + (size_t)r0 * 1024 + col;
            const bf16_t* gp = p.gbuf + (size_t)r0 * 1024 + col;
            bf16_t* op = p.h + (size_t)r0 * 1024 + col;
            if (!isB) attn_block<0>(lds, Kb, Vb, 4, 0, qp, 1024, gp, 1024, op, 0.f, 0, nullptr, 0);
            else attn_block<1>(lds, Kb, Vb, 4, 0, qp, 1024, gp, 1024, op, p.b_sink[j * 8 + head] * LOG2E, 0, nullptr, 0);
        }
    }
}

constexpr int CT = 8;
DI void conv_item(const Params& p, int j, int rbase  , int seglen, int t0, char* lds) {
    const int tid = otid(), lane = tid & 63, w = tid >> 6;
    const int c = 2 * tid;
    float wt[31][2];
    const float* wb = p.c_dw_w + (size_t)j * 31 * 512 + c;
    const bf16_t* cb = p.cbuf + (size_t)rbase * 1536 + c;
    asm volatile("" : "+v"(wb));
    asm volatile("" : "+v"(cb));
#pragma unroll
    for (int k = 0; k < 31; ++k) { const f32x2 v = *(const f32x2*)(wb + k * 512); wt[k][0] = v[0]; wt[k][1] = v[1]; }
    const f32x2 bias = *(const f32x2*)(p.c_dw_b + j * 512 + c);
    float acc[CT][2];
#pragma unroll
    for (int o = 0; o < CT; ++o) { acc[o][0] = bias[0]; acc[o][1] = bias[1]; }
#pragma unroll
    for (int i = 0; i < CT + 30; ++i) {
        const int pos = t0 - 15 + i;
        float u0 = 0.f, u1 = 0.f;
        if (pos >= 0 && pos < seglen) {
            const bf16_t* rp = cb + (ptrdiff_t)pos * 1536;
            const unsigned a = *(const unsigned*)rp, g = *(const unsigned*)(rp + 512);
            u0 = bf_lo(a) * sigmoid_f(bf_lo(g)); u1 = bf_hi(a) * sigmoid_f(bf_hi(g));
        }
#pragma unroll
        for (int o = 0; o < CT; ++o) {
            const int k = i - o;
            if (k >= 0 && k < 31) { acc[o][0] += wt[k][0] * u0; acc[o][1] += wt[k][1] * u1; }
        }
    }
    float* red = (float*)lds;
    float* stat = red + 128;
    __syncthreads();
#pragma unroll
    for (int o = 0; o < CT; ++o) {
        float s1 = acc[o][0] + acc[o][1], s2 = acc[o][0] * acc[o][0] + acc[o][1] * acc[o][1];
#pragma unroll
        for (int sh = 32; sh >= 1; sh >>= 1) { s1 += __shfl_xor(s1, sh); s2 += __shfl_xor(s2, sh); }
        if (lane == 0) { red[(o * 4 + w) * 2] = s1; red[(o * 4 + w) * 2 + 1] = s2; }
    }
    __syncthreads();
    if (tid < CT) {
        float s1 = 0.f, s2 = 0.f;
#pragma unroll
        for (int q = 0; q < 4; ++q) { s1 += red[(tid * 4 + q) * 2]; s2 += red[(tid * 4 + q) * 2 + 1]; }
        const float mean = s1 * (1.0f / 512.0f);
        const float var = fmaxf(s2 * (1.0f / 512.0f) - mean * mean, 0.f);
        stat[tid * 2] = mean; stat[tid * 2 + 1] = rsqrtf(var + EPS);
    }
    __syncthreads();
    const f32x2 lg = *(const f32x2*)(p.c_ln_g + j * 512 + c), lb = *(const f32x2*)(p.c_ln_b + j * 512 + c);
#pragma unroll
    for (int o = 0; o < CT; ++o) {
        const f32x2 st = *(const f32x2*)(stat + 2 * o);
        const float mean = st[0], rstd = st[1];
        const size_t r = (size_t)(rbase + t0 + o);
        const unsigned sg = *(const unsigned*)(cb + (ptrdiff_t)(t0 + o) * 1536 + 1024);
        const float y0 = silu_f((acc[o][0] - mean) * rstd * lg[0] + lb[0]) * bf_lo(sg);
        const float y1 = silu_f((acc[o][1] - mean) * rstd * lg[1] + lb[1]) * bf_hi(sg);
        *(unsigned*)(p.h + r * 1024 + c) = pk2(y0, y1);
    }
}

DI void odd_mix_phase(const Params& p, int layer, char* lds) {
    const int j = layer >> 1;
    const bool upd = layer < 3;
    const int tid = otid(), w = __builtin_amdgcn_readfirstlane(tid >> 6);
    const int total = 3072 + (upd ? 384 : 0);
    float* rpb_lds = (float*)(lds + 2 * 64 * LROW);
    for (int item = blockIdx.x; item < total; item += gridDim.x) {
        if (item < 1024) {
            const int b = item >> 7, hd = (item >> 4) & 7, rp = item & 15;
            __syncthreads();
            for (int i = tid; i < 465; i += 256) rpb_lds[i] = p.d_rpb[((size_t)j * 8 + hd) * 465 + i];
            const int rq = 2 * rp + (w >> 1);
            const int lo_row = min(max(2 * rp - 4, 0), 24), hi_row = min(max(2 * rp + 1 - 4, 0), 24) + 8;
            const int tq0 = rq * 64 + (w & 1) * 32;
            const int r0 = b * TB + CTX + tq0;
            const bf16_t* Kb = p.kbuf + (size_t)(b * 8 + hd) * TB * 64;
            const bf16_t* Vb = p.vT + (size_t)(b * 8 + hd) * 64 * TB;
            attn_block<2>(lds, Kb, Vb, 4 + (hi_row - lo_row), lo_row * 64, p.qbuf + (size_t)r0 * 512 + hd * 64, 512, p.gbuf + (size_t)r0 * 512 + hd * 64, 512,
                          p.h + (size_t)r0 * 1024 + 512 + hd * 64, 0.f, tq0, rpb_lds, rq);
        } else if (item >= 3072 && item < 3200) {
            const int idx = item - 3072, b = idx >> 4, hd = (idx >> 1) & 7, half = idx & 1;
            const int r0 = b * TB + half * 128 + w * 32;
            const bf16_t* Kb = p.kbuf + (size_t)(b * 8 + hd) * TB * 64;
            const bf16_t* Vb = p.vT + (size_t)(b * 8 + hd) * 64 * TB;
            attn_block<0>(lds, Kb, Vb, 4, 0, p.qbuf + (size_t)r0 * 512 + hd * 64, 512, p.gbuf + (size_t)r0 * 512 + hd * 64, 512,
                          p.h + (size_t)r0 * 1024 + 512 + hd * 64, 0.f, 0, nullptr, 0);
        } else {
            int rbase, seglen, t0;
            if (item < 3072) { const int idx = item - 1024; rbase = (idx >> 8) * TB + CTX; seglen = SEQ; t0 = (idx & 255) * CT; }
            else { const int idx = item - 3200; rbase = (idx >> 5) * TB; seglen = CTX; t0 = (idx & 31) * CT; }
            conv_item(p, j, rbase, seglen, t0, lds);
        }
    }
}

#ifndef PMASK
#define PMASK 0xff
#endif
DI void run_phase(const Params& p, int ph, char* lds) {
    if (ph == 0) { if (PMASK & 1) phase0(p, lds); return; }
    if (ph == 17) { if (PMASK & 2) final_phase(p); return; }
    const int layer = (ph - 1) >> 2, sub = (ph - 1) & 3;
    if (sub == 0) { if (PMASK & 4) norm_phase(p, layer); }
    else if (sub == 1) { if (PMASK & 8) gemm_in_phase(p, layer, lds); }
    else if (sub == 2) { if (layer & 1) { if (PMASK & 16) odd_mix_phase(p, layer, lds); } else { if (PMASK & 32) even_mix_phase(p, layer, lds); } }
    else { if (PMASK & 64) gemm_out_phase(p, layer, lds); }
}

__global__ void __launch_bounds__(256, 2) fwd_kernel(Params p, int ph0, int ph1) {
    __shared__ __attribute__((aligned(16))) char lds[LDS_BYTES];
    __shared__ uint4 xb_words;
    XcdBarrier xb;
    const bool multi = (ph1 - ph0) > 1;
    if (multi) {
        if (threadIdx.x == 0) xb_words = make_uint4(0u, 0u, 0u, 0u);
        __syncthreads();
        xb = xcd_barrier_post(p.bar, (volatile LAS unsigned*)&xb_words);
    }
    for (int ph = ph0; ph < ph1; ++ph) {
        if (ph > ph0) xcd_barrier(xb);
        run_phase(p, ph, lds);
    }
}

extern "C" void kernel_launch(void* const* d_in, const int* in_sizes, int n_in, void* d_out, int out_size, void* d_ws, size_t ws_size, hipStream_t stream) {
    Params p{};
    p.x = (const float*)d_in[0]; p.c = (const float*)d_in[1]; p.ctx = (const float*)d_in[2]; p.c_ctx = (const float*)d_in[3];
    p.mod_w = (const float*)d_in[4]; p.mod_b = (const float*)d_in[5]; p.norm_g = (const float*)d_in[6];
    p.ev_w_in = (const float*)d_in[7]; p.ev_w_out = (const float*)d_in[8]; p.a_q_gain = (const float*)d_in[9]; p.a_k_gain = (const float*)d_in[10]; p.b_sink = (const float*)d_in[11];
    p.od_w_in = (const float*)d_in[12]; p.od_w_out = (const float*)d_in[13]; p.c_dw_w = (const float*)d_in[14]; p.c_dw_b = (const float*)d_in[15];
    p.c_ln_g = (const float*)d_in[16]; p.c_ln_b = (const float*)d_in[17]; p.d_rpb = (const float*)d_in[18]; p.final_g = (const float*)d_in[19];
    p.out = (float*)d_out;
    char* ws = (char*)d_ws; size_t off = 0;
    auto take = [&](size_t bytes) { char* r = ws + off; off += (bytes + 255) & ~(size_t)255; return r; };
    p.bar = (unsigned*)take(XCD_BAR_WORDS * 4);
    p.mvec = (float*)take((size_t)4 * 9 * 3072 * 4);
    p.rope = (float*)take((size_t)2048 * 64 * 4);
    p.wt_ev_in = (bf16_t*)take((size_t)2 * 2560 * 1024 * 2);
    p.wt_ev_out = (bf16_t*)take((size_t)2 * 1024 * 1024 * 2);
    p.wt_od_in = (bf16_t*)take((size_t)2 * 3584 * 1024 * 2);
    p.wt_od_out = (bf16_t*)take((size_t)2 * 1024 * 1024 * 2);
    p.xctx = (float*)take((size_t)NB * CTX * DM * 4);
    p.h = (bf16_t*)take((size_t)MROWS * 1024 * 2);
    p.qbuf = (bf16_t*)take((size_t)MROWS * 1024 * 2);
    p.gbuf = (bf16_t*)take((size_t)MROWS * 1024 * 2);
    p.cbuf = (bf16_t*)take((size_t)MROWS * 1536 * 2);
    p.kbuf = (bf16_t*)take((size_t)NB * 8 * TB * 64 * 2);
    p.vT = (bf16_t*)take((size_t)NB * 8 * 64 * TB * 2);
    if (off > ws_size) { fprintf(stderr, "workspace too small: need %zu have %zu\n", off, ws_size); return; }

    static int grid_blocks = 0;
    if (!grid_blocks) {
        int dev = 0, cus = 0, per_cu = 0;
        hipGetDevice(&dev);
        hipDeviceGetAttribute(&cus, hipDeviceAttributeMultiprocessorCount, dev);
        hipOccupancyMaxActiveBlocksPerMultiprocessor(&per_cu, fwd_kernel, 256, 0);
        if (per_cu > 2) per_cu = 2;
        if (per_cu < 1) per_cu = 1;
        grid_blocks = cus * per_cu;
        grid_blocks &= ~7;
    }
#if MULTI_LAUNCH
    for (int ph = 0; ph < 18; ++ph) hipLaunchKernelGGL(fwd_kernel, dim3(grid_blocks), dim3(256), 0, stream, p, ph, ph + 1);
#else
    hipMemsetAsync(p.bar, 0, XCD_BAR_WORDS * 4, stream);
    int ph0 = 0, ph1 = 18;
    void* args[] = {&p, &ph0, &ph1};
    hipError_t e = hipLaunchCooperativeKernel((void*)fwd_kernel, dim3(grid_blocks), dim3(256), args, 0, stream);
    if (e != hipSuccess) fprintf(stderr, "cooperative launch failed: %s (grid %d)\n", hipGetErrorString(e), grid_blocks);
#endif
}
```

```cpp
#include <hip/hip_runtime.h>
#include <hip/hip_cooperative_groups.h>
#include <cstdint>
#include <cstdio>

#ifndef MULTI_LAUNCH
#define MULTI_LAUNCH 0
#endif

#define DI __device__ __forceinline__
#define LAS __attribute__((address_space(3)))

typedef unsigned short bf16_t;
typedef short bf16x8 __attribute__((ext_vector_type(8)));
typedef float f32x16 __attribute__((ext_vector_type(16)));
typedef float f32x4 __attribute__((ext_vector_type(4)));
typedef float f32x2 __attribute__((ext_vector_type(2)));
typedef unsigned u32x4 __attribute__((ext_vector_type(4)));
typedef unsigned u32x2 __attribute__((ext_vector_type(2)));
typedef __bf16 bf16v2 __attribute__((ext_vector_type(2)));

constexpr int NB = 8, SEQ = 2048, DM = 1024, CTX = 256, TB = 2304, MROWS = NB * TB;
constexpr float EPS = 1e-6f, LOG2E = 1.4426950408889634f;
constexpr int LROW = 144;
constexpr int GT_BYTES = 128 * LROW;
constexpr int LDS_BYTES = 73728;

struct Params {
    const float *x, *c, *ctx, *c_ctx, *mod_w, *mod_b, *norm_g, *ev_w_in, *ev_w_out, *a_q_gain, *a_k_gain, *b_sink,
        *od_w_in, *od_w_out, *c_dw_w, *c_dw_b, *c_ln_g, *c_ln_b, *d_rpb, *final_g;
    float* out;
    unsigned* bar;
    float* mvec;
    float* rope;
    bf16_t *wt_ev_in, *wt_ev_out, *wt_od_in, *wt_od_out;
    float* xctx;
    bf16_t* h;
    bf16_t* qbuf;
    bf16_t* gbuf;
    bf16_t* cbuf;
    bf16_t* kbuf;
    bf16_t* vT;
};

DI unsigned pk2(float a, float b) { f32x2 v = {a, b}; bf16v2 r = __builtin_convertvector(v, bf16v2); return __builtin_bit_cast(unsigned, r); }
DI float bf_lo(unsigned u) { return __uint_as_float(u << 16); }
DI float bf_hi(unsigned u) { return __uint_as_float(u & 0xffff0000u); }
DI float silu_f(float x) { return x * __builtin_amdgcn_rcpf(1.f + __builtin_amdgcn_exp2f(-LOG2E * x)); }
DI float sigmoid_f(float x) { return __builtin_amdgcn_rcpf(1.f + __builtin_amdgcn_exp2f(-LOG2E * x)); }
DI int otid() { int t = threadIdx.x; asm volatile("" : "+v"(t)); return t; }
DI float max3f(float a, float b, float c) { float r; asm("v_max3_f32 %0, %1, %2, %3" : "=v"(r) : "v"(a), "v"(b), "v"(c)); return r; }
#define MFMA32(a, b, c) __builtin_amdgcn_mfma_f32_32x32x16_bf16((a), (b), (c), 0, 0, 0)

DI const float* res_in_row(const Params& p, int layer, int r) {
    const int b = r / TB, t = r - b * TB;
    if (t < CTX) return (layer == 0 ? p.ctx : (const float*)p.xctx) + (size_t)(b * CTX + t) * DM;
    return (layer == 0 ? p.x : (const float*)p.out) + (size_t)(b * SEQ + t - CTX) * DM;
}
DI float* res_out_row(const Params& p, int r) {
    const int b = r / TB, t = r - b * TB;
    if (t < CTX) return p.xctx + (size_t)(b * CTX + t) * DM;
    return p.out + (size_t)(b * SEQ + t - CTX) * DM;
}

#define XB_TMO      128
#define XB_XCNT(j)  (256  + 64 * (j))
#define XB_XSUB(j)  (1280 + 64 * (j))
#define XB_XGEN(j)  (2304 + 64 * (j))
#define XB_TOP      3328
#define XB_TOPGEN   3392
#define XB_LSUB(j)  (3456 + 64 * (j))
#define XB_LGEN(j)  (4480 + 64 * (j))
#define XCD_BAR_WORDS 5504
#define XB_SPIN_CAP (1u << 22)
DI unsigned xb_ld(unsigned* p) { return __hip_atomic_load(p, __ATOMIC_RELAXED, __HIP_MEMORY_SCOPE_AGENT); }
DI unsigned xb_add(unsigned* p, unsigned v) { return __hip_atomic_fetch_add(p, v, __ATOMIC_RELAXED, __HIP_MEMORY_SCOPE_AGENT); }
DI unsigned xb_xcc_id() { return (unsigned)__builtin_amdgcn_s_getreg((3 << 11) | 20) & 0xFu; }
#define XB_SPIN(cond, bar) do { unsigned _sp = 0; while (cond) { __builtin_amdgcn_s_sleep(1); \
    if ((++_sp & 255u) == 0u) { if (xb_ld(&(bar)[XB_TMO])) break; if (_sp > XB_SPIN_CAP) { atomicAdd(&(bar)[XB_TMO], 1u); break; } } } } while (0)
struct XcdBarrier { unsigned* bar; unsigned x; volatile LAS unsigned* st; };
DI XcdBarrier xcd_barrier_post(unsigned* bar, volatile LAS unsigned* st) {
    XcdBarrier b; b.bar = bar; b.x = xb_xcc_id(); b.st = st;
    if (threadIdx.x == 0) st[3] = xb_add(&bar[XB_XCNT(b.x)], 1u);
    return b;
}
DI void xcd_barrier_complete(unsigned* bar, unsigned x, unsigned& nloc, unsigned& nx, unsigned& xidx) {
    const unsigned G = gridDim.x * gridDim.y * gridDim.z;
    unsigned sum, cnt, mine, below, sp = 0u;
    for (;;) {
        sum = 0u; cnt = 0u; mine = 0u; below = 0u;
#pragma unroll
        for (unsigned j = 0; j < 16; ++j) { const unsigned c = xb_ld(&bar[XB_XCNT(j)]); sum += c; cnt += (c > 0u) ? 1u : 0u; mine = (j == x) ? c : mine; below += (c > 0u && j < x) ? 1u : 0u; }
        if (sum == G) break;
        __builtin_amdgcn_s_sleep(1);
        if ((++sp & 255u) == 0u) { if (xb_ld(&bar[XB_TMO])) break; if (sp > XB_SPIN_CAP) { atomicAdd(&bar[XB_TMO], 1u); break; } }
    }
    nloc = mine > 0u ? mine : 1u; nx = cnt > 0u ? cnt : 1u; xidx = below;
}
DI void xcd_barrier(const XcdBarrier& b) {
    asm volatile("s_waitcnt vmcnt(0)" ::: "memory");
    __syncthreads();
    if (threadIdx.x == 0) {
        unsigned* bar = b.bar;
        asm volatile("" : "+s"(bar));
        __builtin_amdgcn_s_waitcnt(0);
        unsigned nloc = b.st[0], nx = b.st[1];
        if (nloc == 0u) { unsigned xidx; xcd_barrier_complete(bar, b.x, nloc, nx, xidx); b.st[0] = nloc; b.st[1] = nx; b.st[2] = xidx; }
        const unsigned old = xb_add(&bar[XB_XSUB(b.x)], 1u);
        const unsigned gen = old / nloc;
        if (old + 1u == (gen + 1u) * nloc) {
            __builtin_amdgcn_fence(__ATOMIC_RELEASE, "agent");
            asm volatile("s_waitcnt vmcnt(0)" ::: "memory");
            const unsigned og = xb_add(&bar[XB_TOP], 1u);
            const unsigned tg = og / nx;
            if (og + 1u == (tg + 1u) * nx) xb_add(&bar[XB_TOPGEN], 1u);
            else XB_SPIN(xb_ld(&bar[XB_TOPGEN]) == tg, bar);
            __builtin_amdgcn_fence(__ATOMIC_ACQUIRE, "agent");
            xb_add(&bar[XB_XGEN(b.x)], 1u);
            asm volatile("s_waitcnt vmcnt(0)" ::: "memory");
        } else {
            XB_SPIN(xb_ld(&bar[XB_XGEN(b.x)]) == gen, bar);
            __builtin_amdgcn_fence(__ATOMIC_ACQUIRE, "agent");
            asm volatile("s_waitcnt vmcnt(0)" ::: "memory");
        }
    }
    __syncthreads();
}

DI void xcc_barrier(const XcdBarrier& b) {
    asm volatile("s_waitcnt vmcnt(0)" ::: "memory");
    __syncthreads();
    if (threadIdx.x == 0) {
        unsigned* bar = b.bar;
        asm volatile("" : "+s"(bar));
        __builtin_amdgcn_s_waitcnt(0);
        const unsigned nloc = b.st[0];
        const unsigned old = xb_add(&bar[XB_LSUB(b.x)], 1u);
        const unsigned gen = old / nloc;
        if (old + 1u == (gen + 1u) * nloc) xb_add(&bar[XB_LGEN(b.x)], 1u);
        else XB_SPIN(xb_ld(&bar[XB_LGEN(b.x)]) == gen, bar);
        __builtin_amdgcn_fence(__ATOMIC_ACQUIRE, "agent");
        asm volatile("s_waitcnt vmcnt(0)" ::: "memory");
    }
    __syncthreads();
}

struct Grp { int xcd, local, nlocal, nx; };

DI void mod_item(const Params& p, char* lds, int item) {
    const int tid = otid();
    const int layer = item / 48, n0 = (item % 48) * 64;
    float* sc = (float*)lds;
    float* part = (float*)(lds + 36864);
    __syncthreads();
    for (int i = tid; i < 9 * 1024; i += 256) { const int j = i >> 10, k = i & 1023; const float v = (j < 8) ? p.c[j * 1024 + k] : p.c_ctx[k]; sc[i] = silu_f(v); }
    __syncthreads();
    const int kg = tid >> 4, c4 = (tid & 15) * 4;
    f32x4 acc[9];
#pragma unroll
    for (int j = 0; j < 9; ++j) acc[j] = (f32x4){0.f, 0.f, 0.f, 0.f};
    const float* wp = p.mod_w + ((size_t)layer * 1024 + kg * 64) * 3072 + n0 + c4;
    const float* scp = sc + kg * 64;
#pragma unroll 16
    for (int k = 0; k < 64; ++k) {
        const f32x4 wv = *(const f32x4*)(wp + (size_t)k * 3072);
#pragma unroll
        for (int j = 0; j < 9; ++j) { const float sv = scp[j * 1024 + k]; acc[j] += wv * sv; }
    }
#pragma unroll
    for (int j = 0; j < 9; ++j) *(f32x4*)(part + (kg * 9 + j) * 64 + c4) = acc[j];
    __syncthreads();
    for (int i = tid; i < 9 * 64; i += 256) {
        const int j = i >> 6, cc = i & 63;
        float sm = p.mod_b[layer * 3072 + n0 + cc];
#pragma unroll
        for (int g = 0; g < 16; ++g) sm += part[(g * 9 + j) * 64 + cc];
        p.mvec[((size_t)layer * 9 + j) * 3072 + n0 + cc] = sm;
    }
}

DI void rope_item(const Params& p, int item) {
    const int idx = item * 256 + otid();
    const int t = idx >> 5, pp = idx & 31;
    const float pos = (float)((pp < 16) ? (t >> 6) : (t & 63));
    const float freq = powf(10000.0f, -(float)(pp & 15) / 16.0f);
    const float ang = pos * freq;
    float sn, cs; sincosf(ang, &sn, &cs);
    *(f32x2*)(p.rope + (size_t)idx * 2) = (f32x2){cs, sn};
}

DI void wconv_item(const float* __restrict__ W, bf16_t* __restrict__ Wt, int N, int tile, char* lds) {
    const int tid = otid();
    const int ntn = N >> 6, kt = tile / ntn, nt_ = tile - kt * ntn, k0 = kt * 64, n0 = nt_ * 64;
    float* tl = (float*)lds;
    __syncthreads();
#pragma unroll
    for (int j = 0; j < 4; ++j) {
        const int kk = (tid >> 4) + 16 * j, nn = (tid & 15) * 4;
        const f32x4 v = *(const f32x4*)(W + (size_t)(k0 + kk) * N + n0 + nn);
        tl[kk * 65 + nn + 0] = v[0]; tl[kk * 65 + nn + 1] = v[1]; tl[kk * 65 + nn + 2] = v[2]; tl[kk * 65 + nn + 3] = v[3];
    }
    __syncthreads();
#pragma unroll
    for (int j = 0; j < 2; ++j) {
        const int idx = tid + 256 * j, n = idx >> 3, kc = (idx & 7) * 8;
        u32x4 o;
        o[0] = pk2(tl[(kc + 0) * 65 + n], tl[(kc + 1) * 65 + n]);
        o[1] = pk2(tl[(kc + 2) * 65 + n], tl[(kc + 3) * 65 + n]);
        o[2] = pk2(tl[(kc + 4) * 65 + n], tl[(kc + 5) * 65 + n]);
        o[3] = pk2(tl[(kc + 6) * 65 + n], tl[(kc + 7) * 65 + n]);
        *(u32x4*)(Wt + (size_t)(n0 + n) * 1024 + k0 + kc) = o;
    }
}

DI void phase0(const Params& p, char* lds) {
    const int total = 192 + 256 + 4096;
    for (int item = blockIdx.x; item < total; item += gridDim.x) {
        if (item < 192) mod_item(p, lds, item);
        else if (item < 448) rope_item(p, item - 192);
        else {
            int w = item - 448; const int j = w >> 11; w &= 2047;
            if (w < 640) wconv_item(p.ev_w_in + (size_t)j * 1024 * 2560, p.wt_ev_in + (size_t)j * 2560 * 1024, 2560, w, lds);
            else if (w < 896) wconv_item(p.ev_w_out + (size_t)j * 1024 * 1024, p.wt_ev_out + (size_t)j * 1024 * 1024, 1024, w - 640, lds);
            else if (w < 1792) wconv_item(p.od_w_in + (size_t)j * 1024 * 3584, p.wt_od_in + (size_t)j * 3584 * 1024, 3584, w - 896, lds);
            else wconv_item(p.od_w_out + (size_t)j * 1024 * 1024, p.wt_od_out + (size_t)j * 1024 * 1024, 1024, w - 1792, lds);
        }
    }
}

DI void norm_phase(const Params& p, int layer, const Grp& grp) {
    const int lane = otid() & 63, w = otid() >> 6;
    const float* g = p.norm_g + layer * 1024;
    const int local = grp.local, nlocal = grp.nlocal;
    for (int xcd = grp.xcd; xcd < NB; xcd += grp.nx)
#pragma unroll 1
        for (int seg = 0; seg < 2; ++seg) {
            const int cond = seg ? xcd : 8;
            const float* mv = p.mvec + ((size_t)layer * 9 + cond) * 3072;
            f32x4 mul[4], add[4];
#pragma unroll
            for (int j = 0; j < 4; ++j) {
                const int c0 = lane * 4 + 256 * j;
                const f32x4 gg = *(const f32x4*)(g + c0), sh = *(const f32x4*)(mv + c0), sc = *(const f32x4*)(mv + 1024 + c0);
#pragma unroll
                for (int e = 0; e < 4; ++e) { mul[j][e] = gg[e] * (1.f + sc[e]); add[j][e] = sh[e]; }
            }
            const int i0 = seg ? CTX / 4 : 0, i1 = seg ? TB / 4 : CTX / 4;
            for (int li = i0 + local; li < i1; li += nlocal) {
                const int r = (xcd * (TB / 4) + li) * 4 + w;
                const float* xr = res_in_row(p, layer, r);
                f32x4 v[4]; float ss = 0.f;
#pragma unroll
                for (int j = 0; j < 4; ++j) { v[j] = *(const f32x4*)(xr + lane * 4 + 256 * j); ss += v[j][0] * v[j][0] + v[j][1] * v[j][1] + v[j][2] * v[j][2] + v[j][3] * v[j][3]; }
#pragma unroll
                for (int o = 32; o >= 1; o >>= 1) ss += __shfl_xor(ss, o);
                const float rstd = rsqrtf(ss * (1.0f / 1024.0f) + EPS);
                bf16_t* hr = p.h + (size_t)r * 1024;
#pragma unroll
                for (int j = 0; j < 4; ++j) {
                    const int c0 = lane * 4 + 256 * j;
                    float y[4];
#pragma unroll
                    for (int e = 0; e < 4; ++e) y[e] = (v[j][e] * rstd) * mul[j][e] + add[j][e];
                    *(u32x2*)(hr + c0) = (u32x2){pk2(y[0], y[1]), pk2(y[2], y[3])};
                }
            }
        }
}

DI void final_phase(const Params& p, const Grp& g) {
    const int lane = otid() & 63, w = otid() >> 6;
    const int local = g.local, nlocal = g.nlocal;
    f32x4 fg[4];
#pragma unroll
    for (int j = 0; j < 4; ++j) fg[j] = *(const f32x4*)(p.final_g + lane * 4 + 256 * j);
    for (int xcd = g.xcd; xcd < NB; xcd += g.nx)
    for (int li = local; li < SEQ / 4; li += nlocal) {
        const int item = xcd * (SEQ / 4) + li;
        const int r = item * 4 + w;
        float* xr = p.out + (size_t)r * 1024;
        f32x4 v[4]; float ss = 0.f;
#pragma unroll
        for (int j = 0; j < 4; ++j) { v[j] = *(const f32x4*)(xr + lane * 4 + 256 * j); ss += v[j][0] * v[j][0] + v[j][1] * v[j][1] + v[j][2] * v[j][2] + v[j][3] * v[j][3]; }
#pragma unroll
        for (int o = 32; o >= 1; o >>= 1) ss += __shfl_xor(ss, o);
        const float rstd = rsqrtf(ss * (1.0f / 1024.0f) + EPS);
#pragma unroll
        for (int j = 0; j < 4; ++j) {
            const int c0 = lane * 4 + 256 * j;
            f32x4 o;
#pragma unroll
            for (int e = 0; e < 4; ++e) o[e] = v[j][e] * rstd * fg[j][e];
            *(f32x4*)(xr + c0) = o;
        }
    }
}

DI void dma16(const void* gsrc, unsigned lds_dst) { unsigned keep;
    asm volatile("s_mov_b32 %0, m0\n\ts_mov_b32 m0, %2\n\ts_nop 0\n\tglobal_load_lds_dwordx4 %1, off\n\ts_mov_b32 m0, %0" : "=&s"(keep) : "v"(gsrc), "s"(lds_dst) : "memory"); }
DI void dma16s(const void* base, unsigned voff, unsigned lds_dst) { unsigned keep;
    asm volatile("s_mov_b32 %0, m0\n\ts_mov_b32 m0, %3\n\ts_nop 0\n\tglobal_load_lds_dwordx4 %1, %2\n\ts_mov_b32 m0, %0" : "=&s"(keep) : "v"(voff), "s"(base), "s"(lds_dst) : "memory"); }
#define WAIT_BAR(N) asm volatile("s_waitcnt vmcnt(" #N ") lgkmcnt(0)\n\ts_barrier" ::: "memory")
#define WAIT_VM(n) asm volatile("s_waitcnt vmcnt(" #n ")" ::: "memory")

template <bool SWAP, int TI, int GP = 0>
DI void gemm_mainloop(const bf16_t* __restrict__ A, const bf16_t* __restrict__ W, int row0, int col0, f32x16 (&acc)[2 * TI], char* lds, bool pre_issued) {
    constexpr int MT = 64 * TI, STAGE = (MT + 128) * 64, NST = (TI == 4) ? 3 : 4, NA = TI, KT = 32;
    const int tid = otid(), lane = tid & 63, w = __builtin_amdgcn_readfirstlane(tid >> 6), wm = w >> 1, wn = w & 1, l31 = lane & 31, hh = lane >> 5;
    const int cc = (lane & 3) ^ ((lane >> 4) & 3);
    const unsigned pa = (unsigned)(((row0 + 16 * w + (lane >> 2)) * 1024 + cc * 8) * 2);
    const unsigned pb = (unsigned)(((col0 + 16 * w + (lane >> 2)) * 1024 + cc * 8) * 2);
    const unsigned l3 = (unsigned)(size_t)lds + w * 1024;
    const int sw = (l31 >> 2) & 3;
    const char* fa = lds + (wm * (32 * TI) + l31) * 64;
    const char* fb = lds + MT * 64 + (wn * 64 + l31) * 64;
    const int ch0 = ((0 + hh) ^ sw) * 16, ch1 = ((2 + hh) ^ sw) * 16;
#pragma unroll
    for (int i = 0; i < 2 * TI; ++i)
#pragma unroll
        for (int e = 0; e < 16; ++e) acc[i][e] = 0.f;
    if (!pre_issued) WAIT_BAR(0);
#define GEMM_ISSUE(kt, st) do { const unsigned _sb = l3 + (st) * STAGE; const int _ko = (kt) * 32; \
        _Pragma("unroll") for (int _j = 0; _j < NA; ++_j) dma16s(A, pa + (_j * 64 * 1024 + _ko) * 2, _sb + _j * 4096); \
        _Pragma("unroll") for (int _j = 0; _j < 2; ++_j) dma16s(W, pb + (_j * 64 * 1024 + _ko) * 2, _sb + MT * 64 + _j * 4096); } while (0)
#define GEMM_STAGE(DO_ISSUE, ktn) do { \
        const char* sa = fa + rs * STAGE; const char* sb = fb + rs * STAGE; \
        const unsigned _sbase = l3 + is * STAGE; const int _ko = (ktn) * 32; \
        bf16x8 af[2][TI], bf[2][2]; \
        _Pragma("unroll") for (int ks = 0; ks < 2; ++ks) { const int ch = ks ? ch1 : ch0; \
            _Pragma("unroll") for (int i = 0; i < TI; ++i) af[ks][i] = *(const bf16x8*)(sa + i * 32 * 64 + ch); \
            _Pragma("unroll") for (int j = 0; j < 2; ++j) bf[ks][j] = *(const bf16x8*)(sb + j * 32 * 64 + ch); } \
        _Pragma("unroll") for (int m = 0; m < 4 * TI; ++m) { \
            const int ks = m / (2 * TI), i = (m % (2 * TI)) >> 1, j = m & 1; \
            if (SWAP) acc[i * 2 + j] = MFMA32(af[ks][i], bf[ks][j], acc[i * 2 + j]); \
            else      acc[j * TI + i] = MFMA32(bf[ks][j], af[ks][i], acc[j * TI + i]); \
            if (DO_ISSUE && (m & 1) && (m >> 1) < NA + 2) { const int q = m >> 1; \
                __builtin_amdgcn_sched_barrier(0); \
                if (q < NA) dma16s(A, pa + (q * 64 * 1024 + _ko) * 2, _sbase + q * 4096); \
                else dma16s(W, pb + ((q - NA) * 64 * 1024 + _ko) * 2, _sbase + MT * 64 + (q - NA) * 4096); \
                __builtin_amdgcn_sched_barrier(0); } } \
        rs = (rs + 1 == NST) ? 0 : rs + 1; } while (0)
    if (TI == 2) {
        if (!pre_issued) { GEMM_ISSUE(0, 0); GEMM_ISSUE(1, 1); }
        int rs = 0, is = 2;
#pragma unroll 1
        for (int kp = 0; kp < KT / 2 - 1; ++kp) {
            WAIT_BAR(0);
            GEMM_STAGE(true, 2 * kp + 2);
            is = (is + 1) & 3;
            GEMM_STAGE(true, 2 * kp + 3);
            is = (is + 1) & 3;
        }
        WAIT_BAR(0);
        GEMM_STAGE(false, 0);
        GEMM_STAGE(false, 0);
    } else {
    if (!pre_issued) {
#pragma unroll
        for (int s = 0; s < NST - 1; ++s) GEMM_ISSUE(s, s);
    }
    int rs = 0, is = NST - 1;
#pragma unroll 1
    for (int kt = 0; kt < KT - (NST - 1); ++kt) {
        if (TI == 4) WAIT_BAR(6); else WAIT_BAR(8);
        GEMM_STAGE(true, kt + NST - 1);
        is = (is + 1 == NST) ? 0 : is + 1;
    }
#pragma unroll 1
    for (int kt = KT - (NST - 1); kt < KT; ++kt) {
        WAIT_BAR(0);
        GEMM_STAGE(false, 0);
    }
    }
#undef GEMM_STAGE
#undef GEMM_ISSUE
}

template <int TI>
DI void gemm_prefetch(const bf16_t* __restrict__ A, const bf16_t* __restrict__ W, int row0, int col0, char* lds) {
    constexpr int MT = 64 * TI, STAGE = (MT + 128) * 64, NST = (TI == 4) ? 3 : 4, NA = TI;
    const int tid = otid(), lane = tid & 63, w = __builtin_amdgcn_readfirstlane(tid >> 6);
    const int cc = (lane & 3) ^ ((lane >> 4) & 3);
    const unsigned pa = (unsigned)(((row0 + 16 * w + (lane >> 2)) * 1024 + cc * 8) * 2);
    const unsigned pb = (unsigned)(((col0 + 16 * w + (lane >> 2)) * 1024 + cc * 8) * 2);
    const unsigned l3 = (unsigned)(size_t)lds + w * 1024;
    asm volatile("s_waitcnt lgkmcnt(0)\n\ts_barrier" ::: "memory");
#pragma unroll
    for (int s = 0; s < ((TI == 2) ? 2 : NST - 1); ++s) {
        const unsigned sb = l3 + s * STAGE; const int ko = s * 32;
#pragma unroll
        for (int j = 0; j < NA; ++j) dma16s(A, pa + (j * 64 * 1024 + ko) * 2, sb + j * 4096);
#pragma unroll
        for (int j = 0; j < 2; ++j) dma16s(W, pb + (j * 64 * 1024 + ko) * 2, sb + MT * 64 + j * 4096);
    }
}

DI void store_pair16(bf16_t* pairp  , int hh, unsigned a0, unsigned a1, unsigned b0, unsigned b1) {
    const u32x2 r0 = __builtin_amdgcn_permlane32_swap(a0, b0, false, false);
    const u32x2 r1 = __builtin_amdgcn_permlane32_swap(a1, b1, false, false);
    *(u32x4*)(pairp + 8 * hh) = (u32x4){r0[0], r1[0], r0[1], r1[1]};
}

template <int TR, int TI>
DI void epi_plain(const f32x16 (&acc)[2 * TI], bf16_t* dst, int stride, int row0) {
    const int lane = otid() & 63, w = __builtin_amdgcn_readfirstlane(otid() >> 6), wm = w >> 1, l31 = lane & 31, hh = lane >> 5;
#pragma unroll
    for (int ti = 0; ti < TI; ++ti) {
        const int r = row0 + wm * (32 * TI) + 32 * ti + l31;
        bf16_t* rp = dst + (size_t)r * stride;
#pragma unroll
        for (int fi = 0; fi < 2; ++fi)
#pragma unroll
            for (int gp = 0; gp < 2; ++gp) {
                float v[8];
#pragma unroll
                for (int e = 0; e < 8; ++e) { float x = acc[fi * TI + ti][8 * gp + e]; if (TR == 1) x = silu_f(x); if (TR == 2) x *= 0.125f; v[e] = x; }
                store_pair16(rp + 32 * fi + 16 * gp, hh, pk2(v[0], v[1]), pk2(v[2], v[3]), pk2(v[4], v[5]), pk2(v[6], v[7]));
            }
    }
}

template <bool RMS, bool ISQ, int TI>
DI void epi_qk(const Params& p, const f32x16 (&acc)[2 * TI], const float* gain, int row0, bf16_t* qdst  , int kslot, int nkv) {
    const int lane = otid() & 63, w = __builtin_amdgcn_readfirstlane(otid() >> 6), wm = w >> 1, l31 = lane & 31, hh = lane >> 5;
#pragma unroll
    for (int ti = 0; ti < TI; ++ti) {
        const int r = row0 + wm * (32 * TI) + 32 * ti + l31;
        const int b = r / TB, t = r - b * TB;
        float v[2][16];
#pragma unroll
        for (int fi = 0; fi < 2; ++fi)
#pragma unroll
            for (int e = 0; e < 16; ++e) v[fi][e] = acc[fi * TI + ti][e];
        if (RMS) {
            float ss = 0.f;
#pragma unroll
            for (int fi = 0; fi < 2; ++fi)
#pragma unroll
                for (int e = 0; e < 16; ++e) ss += v[fi][e] * v[fi][e];
            ss += __shfl_xor(ss, 32);
            const float rstd = rsqrtf(ss * (1.0f / 64.0f) + EPS);
#pragma unroll
            for (int fi = 0; fi < 2; ++fi)
#pragma unroll
                for (int g = 0; g < 4; ++g) {
                    const f32x4 gg = *(const f32x4*)(gain + 32 * fi + 8 * g + 4 * hh);
#pragma unroll
                    for (int e = 0; e < 4; ++e) v[fi][4 * g + e] = v[fi][4 * g + e] * rstd * gg[e];
                }
        }
        if (t >= CTX) {
            const float* rt = p.rope + (size_t)(t - CTX) * 64;
#pragma unroll
            for (int fi = 0; fi < 2; ++fi)
#pragma unroll
                for (int g = 0; g < 4; ++g) {
                    const f32x4 cs = *(const f32x4*)(rt + (16 * fi + 4 * g + 2 * hh) * 2);
                    const float x0 = v[fi][4 * g + 0], x1 = v[fi][4 * g + 1], x2 = v[fi][4 * g + 2], x3 = v[fi][4 * g + 3];
                    v[fi][4 * g + 0] = x0 * cs[0] - x1 * cs[1];
                    v[fi][4 * g + 1] = x0 * cs[1] + x1 * cs[0];
                    v[fi][4 * g + 2] = x2 * cs[2] - x3 * cs[3];
                    v[fi][4 * g + 3] = x2 * cs[3] + x3 * cs[2];
                }
        }
        bf16_t* rp = ISQ ? (qdst + (size_t)r * 1024) : (p.kbuf + ((size_t)(b * nkv + kslot) * TB + t) * 64);
#pragma unroll
        for (int fi = 0; fi < 2; ++fi)
#pragma unroll
            for (int gp = 0; gp < 2; ++gp) {
                float o[8];
#pragma unroll
                for (int e = 0; e < 8; ++e) o[e] = ISQ ? v[fi][8 * gp + e] * 0.125f : v[fi][8 * gp + e];
                store_pair16(rp + 32 * fi + 16 * gp, hh, pk2(o[0], o[1]), pk2(o[2], o[3]), pk2(o[4], o[5]), pk2(o[6], o[7]));
            }
    }
}

template <int TI>
DI void epi_k_plain(const Params& p, const f32x16 (&acc)[2 * TI], int row0, int kslot, int nkv) {
    const int lane = otid() & 63, w = __builtin_amdgcn_readfirstlane(otid() >> 6), wm = w >> 1, l31 = lane & 31, hh = lane >> 5;
#pragma unroll
    for (int ti = 0; ti < TI; ++ti) {
        const int r = row0 + wm * (32 * TI) + 32 * ti + l31;
        const int b = r / TB, t = r - b * TB;
        bf16_t* rp = p.kbuf + ((size_t)(b * nkv + kslot) * TB + t) * 64;
#pragma unroll
        for (int fi = 0; fi < 2; ++fi)
#pragma unroll
            for (int gp = 0; gp < 2; ++gp)
                store_pair16(rp + 32 * fi + 16 * gp, hh, pk2(acc[fi * TI + ti][8 * gp], acc[fi * TI + ti][8 * gp + 1]), pk2(acc[fi * TI + ti][8 * gp + 2], acc[fi * TI + ti][8 * gp + 3]),
                             pk2(acc[fi * TI + ti][8 * gp + 4], acc[fi * TI + ti][8 * gp + 5]), pk2(acc[fi * TI + ti][8 * gp + 6], acc[fi * TI + ti][8 * gp + 7]));
    }
}

template <int TI>
DI void epi_v(const Params& p, const f32x16 (&acc)[2 * TI], int row0, int vslot, int nkv) {
    const int lane = otid() & 63, w = __builtin_amdgcn_readfirstlane(otid() >> 6), wm = w >> 1, l31 = lane & 31, hh = lane >> 5;
#pragma unroll
    for (int ti = 0; ti < TI; ++ti) {
        const int rb = row0 + wm * (32 * TI) + 32 * ti;
        const int b = rb / TB, tb = rb - b * TB;
#pragma unroll
        for (int fi = 0; fi < 2; ++fi) {
            const int d = 32 * fi + l31;
            bf16_t* vp = p.vT + ((size_t)(b * nkv + vslot) * 64 + d) * TB + tb;
#pragma unroll
            for (int gq = 0; gq < 2; ++gq) {
                u32x4 o;
                o[0] = pk2(acc[ti * 2 + fi][8 * gq + 0], acc[ti * 2 + fi][8 * gq + 1]);
                o[1] = pk2(acc[ti * 2 + fi][8 * gq + 2], acc[ti * 2 + fi][8 * gq + 3]);
                o[2] = pk2(acc[ti * 2 + fi][8 * gq + 4], acc[ti * 2 + fi][8 * gq + 5]);
                o[3] = pk2(acc[ti * 2 + fi][8 * gq + 6], acc[ti * 2 + fi][8 * gq + 7]);
                *(u32x4*)(vp + 16 * gq + 8 * hh) = o;
            }
        }
    }
}

#ifndef GPROBE
#define GPROBE 0
#endif
constexpr int TIN = 4;
DI void gemm_in_phase(const Params& p, int layer, char* lds, const Grp& g, bool do_epi = true) {
    const bool even = (layer & 1) == 0;
    const int j = layer >> 1;
    const int N = even ? 2560 : 3584, nct = N / 128;
    const bf16_t* W = even ? p.wt_ev_in + (size_t)j * 2560 * 1024 : p.wt_od_in + (size_t)j * 3584 * 1024;
    const bool last = (layer == 3);
    const int local = g.local, nlocal = g.nlocal;
    const int wn = __builtin_amdgcn_readfirstlane(otid() >> 6) & 1;
    constexpr int RT_PER_XCD = MROWS / (64 * TIN) / 8;
    const int nli = RT_PER_XCD * nct;
#define GIN_SKIP(li_) (last && ((li_) / nct == 0) && ((((li_) % nct) * 128 < 2048) || (((li_) % nct) * 128 >= 3072)))
    for (int xcd = g.xcd; xcd < NB; xcd += g.nx) {
    int li = local;
    while (li < nli && GIN_SKIP(li)) li += nlocal;
    bool pre = false;
    while (li < nli) {
        const int rtl = li / nct, ct = li - rtl * nct;
        const int rt = xcd * RT_PER_XCD + rtl;
        const int row0 = rt * (64 * TIN), col0 = ct * 128;
        const int c64 = col0 + wn * 64;
        const bool swap = even ? (col0 == 640 || col0 == 1920) : (col0 >= 2560 && col0 < 3072);
        f32x16 acc[2 * TIN];
        if (!do_epi) {
            gemm_mainloop<false, TIN, GPROBE>(p.h, W, row0, col0, acc, lds, false);
            float sm = 0.f;
#pragma unroll
            for (int i = 0; i < 2 * TIN; ++i)
#pragma unroll
                for (int e = 0; e < 16; ++e) sm += acc[i][e];
            if (sm == 12345.678f) p.mvec[0] = sm;
            li += nlocal;
            continue;
        }
        if (swap) gemm_mainloop<true, TIN>(p.h, W, row0, col0, acc, lds, pre);
        else gemm_mainloop<false, TIN>(p.h, W, row0, col0, acc, lds, pre);
        int ln = li + nlocal;
        while (ln < nli && GIN_SKIP(ln)) ln += nlocal;
        pre = ln < nli;
        if (pre) { const int rtl2 = ln / nct, ct2 = ln - rtl2 * nct; gemm_prefetch<TIN>(p.h, W, (xcd * RT_PER_XCD + rtl2) * (64 * TIN), ct2 * 128, lds); }
        li = ln;
        if (even) {
            if (swap) epi_v<TIN>(p, acc, row0, (col0 == 640 ? 0 : 2) + wn, 4);
            else if (col0 < 512) epi_qk<true, true, TIN>(p, acc, p.a_q_gain + j * 64, row0, p.qbuf + c64, 0, 4);
            else if (col0 < 640) epi_qk<true, false, TIN>(p, acc, p.a_k_gain + j * 64, row0, nullptr, wn, 4);
            else if (col0 < 1280) epi_plain<1, TIN>(acc, p.gbuf + (c64 - 768), 1024, row0);
            else if (col0 < 1792) epi_qk<false, true, TIN>(p, acc, nullptr, row0, p.qbuf + 512 + (c64 - 1280), 0, 4);
            else if (col0 < 1920) epi_qk<false, false, TIN>(p, acc, nullptr, row0, nullptr, 2 + wn, 4);
            else epi_plain<1, TIN>(acc, p.gbuf + 512 + (c64 - 2048), 1024, row0);
        } else {
            if (swap) epi_v<TIN>(p, acc, row0, (c64 - 2560) >> 6, 8);
            else if (col0 < 1024) epi_plain<0, TIN>(acc, p.cbuf + c64, 1536, row0);
            else if (col0 < 1536) epi_plain<1, TIN>(acc, p.cbuf + c64, 1536, row0);
            else if (col0 < 2048) epi_plain<2, TIN>(acc, p.qbuf + (c64 - 1536), 512, row0);
            else if (col0 < 2560) epi_k_plain<TIN>(p, acc, row0, (c64 - 2048) >> 6, 8);
            else epi_plain<1, TIN>(acc, p.gbuf + (c64 - 3072), 512, row0);
        }
    }
    }
#undef GIN_SKIP
}

constexpr int TOUT = 2;
DI void gemm_out_phase(const Params& p, int layer, char* lds, const Grp& g) {
    const bool even = (layer & 1) == 0;
    const int j = layer >> 1;
    const bf16_t* W = (even ? p.wt_ev_out : p.wt_od_out) + (size_t)j * 1024 * 1024;
    const bool last = (layer == 3);
    const int local = g.local, nlocal = g.nlocal;
    constexpr int RT_PER_XCD = MROWS / (64 * TOUT) / 8;
    const int nli = RT_PER_XCD * 8;
#define GOUT_SKIP(li_) (last && ((li_) >> 3) < 2)
    for (int xcd = g.xcd; xcd < NB; xcd += g.nx) {
    int li = local;
    while (li < nli && GOUT_SKIP(li)) li += nlocal;
    bool pre = false;
    while (li < nli) {
        const int rtl = li >> 3, ct = li & 7;
        const int rt = xcd * RT_PER_XCD + rtl;
        const int row0 = rt * (64 * TOUT), col0 = ct * 128;
        f32x16 acc[2 * TOUT];
        gemm_mainloop<false, TOUT>(p.h  , W, row0, col0, acc, lds, pre);
        int ln = li + nlocal;
        while (ln < nli && GOUT_SKIP(ln)) ln += nlocal;
        pre = ln < nli;
        if (pre) gemm_prefetch<TOUT>(p.h, W, (xcd * RT_PER_XCD + (ln >> 3)) * (64 * TOUT), (ln & 7) * 128, lds);
        li = ln;
        const int lane = otid() & 63, w = __builtin_amdgcn_readfirstlane(otid() >> 6), wm = w >> 1, wn = w & 1, l31 = lane & 31, hh = lane >> 5;
#pragma unroll
        for (int ti = 0; ti < TOUT; ++ti) {
            const int r = row0 + wm * (32 * TOUT) + 32 * ti + l31;
            const int b = r / TB, t = r - b * TB;
            const int cond = (t < CTX) ? 8 : b;
            const float* gm = p.mvec + ((size_t)layer * 9 + cond) * 3072 + 2048;
            const float* xi = res_in_row(p, layer, r);
            float* xo = res_out_row(p, r);
#pragma unroll
            for (int fi = 0; fi < 2; ++fi)
#pragma unroll
                for (int g = 0; g < 4; ++g) {
                    const int c = col0 + wn * 64 + 32 * fi + 8 * g + 4 * hh;
                    const f32x4 xv = *(const f32x4*)(xi + c), gv = *(const f32x4*)(gm + c);
                    f32x4 o;
#pragma unroll
                    for (int e = 0; e < 4; ++e) o[e] = xv[e] + gv[e] * acc[fi * TOUT + ti][4 * g + e];
                    *(f32x4*)(xo + c) = o;
                }
        }
    }
    }
#undef GOUT_SKIP
}

template <int MODE>
DI void attn_block(char* lds, const bf16_t* __restrict__ Kb, const bf16_t* __restrict__ Vb, int nt, int lat_lo,
                   const bf16_t* __restrict__ qptr, int qstride, const bf16_t* __restrict__ gptr, int gstride, bf16_t* __restrict__ optr,
                   float sink_l2, int tq_base, const float* rpb_lds, int rq) {
    constexpr int ASTAGE = 16384, ANST = 3;
    const int tid = otid(), lane = tid & 63, w = __builtin_amdgcn_readfirstlane(tid >> 6), l31 = lane & 31, hh = lane >> 5;
    const int r8 = lane >> 3;
    const int cc = (lane & 7) ^ (4 * (w & 1) + (r8 >> 1));
    const unsigned kp = (unsigned)(((8 * w + r8) * 64 + cc * 8) * 2);
    const unsigned vp = (unsigned)(((8 * w + r8) * TB + cc * 8) * 2);
    const unsigned l3 = (unsigned)(size_t)lds + w * 1024;
#define ATT_ISSUE(itile, st) do { const int _t0 = ((itile) < 4) ? (itile) * 64 : CTX + lat_lo + ((itile) - 4) * 64; const unsigned _sb = l3 + (st) * ASTAGE; \
        dma16s(Kb, kp + _t0 * 128, _sb); dma16s(Kb, kp + (_t0 + 32) * 128, _sb + 4096); \
        dma16s(Vb, vp + _t0 * 2, _sb + 8192); dma16s(Vb, vp + (32 * TB + _t0) * 2, _sb + 8192 + 4096); } while (0)
    WAIT_BAR(0);
    ATT_ISSUE(0, 0);
    ATT_ISSUE(1, 1);
    bf16x8 qf[4];
#pragma unroll
    for (int ks = 0; ks < 4; ++ks) qf[ks] = *(const bf16x8*)(qptr + (size_t)l31 * qstride + 16 * ks + 8 * hh);
    asm volatile("" :: "v"(qf[0]), "v"(qf[1]), "v"(qf[2]), "v"(qf[3]));
    f32x16 O0, O1;
#pragma unroll
    for (int e = 0; e < 16; ++e) { O0[e] = 0.f; O1[e] = 0.f; }
    float mrun = (MODE == 1) ? sink_l2 : -1e30f;
    f32x16 Lacc;
#pragma unroll
    for (int e = 0; e < 16; ++e) Lacc[e] = (MODE == 1) ? 1.f : 0.f;
    const bf16x8 ones = __builtin_bit_cast(bf16x8, (u32x4){0x3F803F80u, 0x3F803F80u, 0x3F803F80u, 0x3F803F80u});
    const int tq = tq_base + l31;
    int cq = 0, cs_ = 0, rs = 0;
    if (MODE == 2) { cq = tq & 63; cs_ = min(max(cq - 8, 0), 48); rs = min(max(rq - 4, 0), 24); }
    const int swz = (l31 >> 1) & 7;
    const char* kbase = lds + l31 * 128;
    const char* vbase = lds + 8192 + l31 * 128;
    int rst = 0, ist = 2;
#pragma unroll 1
    for (int it = 0; it < nt; ++it) {
        if (it + 1 < nt) WAIT_BAR(4); else WAIT_BAR(0);
        if (it + 2 < nt) { ATT_ISSUE(it + 2, ist); ist = (ist == 2) ? 0 : ist + 1; }
        const char* ldsK = kbase + rst * ASTAGE;
        const char* ldsV = vbase + rst * ASTAGE;
        rst = (rst == 2) ? 0 : rst + 1;
        bool active = true;
        int krow = 0;
        if (MODE == 2 && it >= 4) { krow = (lat_lo >> 6) + it - 4; active = (krow >= rs) && (krow < rs + 8); }
        if (active) {
            f32x16 s0, s1;
#pragma unroll
            for (int e = 0; e < 16; ++e) { s0[e] = 0.f; s1[e] = 0.f; }
            bf16x8 kf[2][4];
#pragma unroll
            for (int ks = 0; ks < 4; ++ks) {
                const int ch = ((2 * ks + hh) ^ swz) * 16;
                kf[0][ks] = *(const bf16x8*)(ldsK + ch);
                kf[1][ks] = *(const bf16x8*)(ldsK + 32 * 128 + ch);
            }
#pragma unroll
            for (int ks = 0; ks < 4; ++ks) {
                s0 = MFMA32(kf[0][ks], qf[ks], s0);
                s1 = MFMA32(kf[1][ks], qf[ks], s1);
            }
            bf16x8 vf[2][4];
#pragma unroll
            for (int q = 0; q < 4; ++q) {
                const int ch = ((2 * q + hh) ^ swz) * 16;
                vf[0][q] = *(const bf16x8*)(ldsV + ch);
                vf[1][q] = *(const bf16x8*)(ldsV + 32 * 128 + ch);
            }
            if (MODE != 2) {
                __builtin_amdgcn_sched_group_barrier(0x100, 8, 0);
                __builtin_amdgcn_sched_group_barrier(0x008, 8, 0);
                __builtin_amdgcn_sched_group_barrier(0x100, 8, 0);
            }
            if (MODE == 1 && it >= 4) {
                const int base = lat_lo + (it - 4) * 64 + 4 * hh - tq + 128;
#pragma unroll
                for (int e = 0; e < 16; ++e) {
                    const int o = (e >> 2) * 8 + (e & 3);
                    s0[e] = ((unsigned)(base + o) <= 256u) ? s0[e] : -1e30f;
                    s1[e] = ((unsigned)(base + 32 + o) <= 256u) ? s1[e] : -1e30f;
                }
            } else if (MODE == 2 && it >= 4) {
                const float* rpl = rpb_lds + (krow - rq + 7) * 31 + (4 * hh - cq + 15);
                const int vt = 4 * hh - cs_;
#pragma unroll
                for (int e = 0; e < 16; ++e) {
                    const int kcst = (e >> 2) * 8 + (e & 3);
                    const float b0 = rpl[kcst], b1 = rpl[kcst + 32];
                    s0[e] = ((unsigned)(kcst + vt) < 16u) ? (s0[e] + b0) : -1e30f;
                    s1[e] = ((unsigned)(kcst + 32 + vt) < 16u) ? (s1[e] + b1) : -1e30f;
                }
            }
            float mx = max3f(s0[0], s1[0], s0[1]);
#pragma unroll
            for (int e = 1; e < 15; ++e) mx = max3f(mx, s1[e], s0[e + 1]);
            mx = max3f(mx, s1[15], s1[15]) * LOG2E;
            if (__any(mx > mrun + 8.0f)) {
                const float mnew = max3f(mrun, mx, __shfl_xor(mx, 32));
                const float alpha = __builtin_amdgcn_exp2f(mrun - mnew);
#pragma unroll
                for (int e = 0; e < 16; ++e) { O0[e] *= alpha; O1[e] *= alpha; Lacc[e] *= alpha; }
                mrun = mnew;
            }
#pragma unroll
            for (int e = 0; e < 16; ++e) {
                s0[e] = __builtin_amdgcn_exp2f(__builtin_fmaf(s0[e], LOG2E, -mrun));
                s1[e] = __builtin_amdgcn_exp2f(__builtin_fmaf(s1[e], LOG2E, -mrun));
            }
            bf16x8 pf[2][2];
#pragma unroll
            for (int s = 0; s < 2; ++s) {
                u32x4 a, b;
                a[0] = pk2(s0[8 * s + 0], s0[8 * s + 1]); a[1] = pk2(s0[8 * s + 2], s0[8 * s + 3]); a[2] = pk2(s0[8 * s + 4], s0[8 * s + 5]); a[3] = pk2(s0[8 * s + 6], s0[8 * s + 7]);
                b[0] = pk2(s1[8 * s + 0], s1[8 * s + 1]); b[1] = pk2(s1[8 * s + 2], s1[8 * s + 3]); b[2] = pk2(s1[8 * s + 4], s1[8 * s + 5]); b[3] = pk2(s1[8 * s + 6], s1[8 * s + 7]);
                pf[0][s] = __builtin_bit_cast(bf16x8, a); pf[1][s] = __builtin_bit_cast(bf16x8, b);
            }
#pragma unroll
            for (int sub = 0; sub < 2; ++sub)
#pragma unroll
                for (int s = 0; s < 2; ++s) {
                    O0 = MFMA32(vf[0][2 * sub + s], pf[sub][s], O0);
                    O1 = MFMA32(vf[1][2 * sub + s], pf[sub][s], O1);
                    Lacc = MFMA32(ones, pf[sub][s], Lacc);
                }
        }
    }
#undef ATT_ISSUE
    const float inv = 1.0f / Lacc[0];
    const bf16_t* gp = gptr + (size_t)l31 * gstride;
    bf16_t* op = optr + (size_t)l31 * 1024;
#pragma unroll
    for (int half = 0; half < 2; ++half)
#pragma unroll
        for (int pr = 0; pr < 2; ++pr) {
            unsigned pk[4];
#pragma unroll
            for (int q = 0; q < 2; ++q) {
                const int g = 2 * pr + q, d = 32 * half + 8 * g + 4 * hh;
                const u32x2 gg = *(const u32x2*)(gp + d);
                const float a0 = (half ? O1[4 * g] : O0[4 * g]), a1 = (half ? O1[4 * g + 1] : O0[4 * g + 1]), a2 = (half ? O1[4 * g + 2] : O0[4 * g + 2]), a3 = (half ? O1[4 * g + 3] : O0[4 * g + 3]);
                pk[2 * q] = pk2(a0 * inv * bf_lo(gg[0]), a1 * inv * bf_hi(gg[0]));
                pk[2 * q + 1] = pk2(a2 * inv * bf_lo(gg[1]), a3 * inv * bf_hi(gg[1]));
            }
            store_pair16(op + 32 * half + 16 * pr, hh, pk[0], pk[1], pk[2], pk[3]);
        }
}

DI void even_mix_phase(const Params& p, int layer, char* lds, const Grp& g) {
    const int j = layer >> 1;
    const bool upd = layer < 3;
    const int w = __builtin_amdgcn_readfirstlane(otid() >> 6);
    const int local = g.local, nlocal = g.nlocal;
    const int per_b = 256 + (upd ? 32 : 0);
    for (int xcd = g.xcd; xcd < NB; xcd += g.nx)
    for (int li = local; li < per_b; li += nlocal) {
        const int item = (li < 128) ? (xcd * 128 + li) : (li < 256) ? (1024 + xcd * 128 + (li - 128)) : (2048 + xcd * 32 + (li - 256));
        if (item < 2048) {
            const bool isB = item >= 1024;
            const int it2 = item & 1023;
            const int b = it2 >> 7, kvh = (it2 >> 6) & 1, qt = it2 & 63;
            const int slot = (isB ? 2 : 0) + kvh;
            const int head = kvh * 4 + w;
            const int col = (isB ? 512 : 0) + head * 64;
            const int r0 = b * TB + CTX + qt * 32;
            const bf16_t* Kb = p.kbuf + (size_t)(b * 4 + slot) * TB * 64;
            const bf16_t* Vb = p.vT + (size_t)(b * 4 + slot) * 64 * TB;
            const bf16_t* qp = p.qbuf + (size_t)r0 * 1024 + col;
            const bf16_t* gp = p.gbuf + (size_t)r0 * 1024 + col;
            bf16_t* op = p.h + (size_t)r0 * 1024 + col;
            if (!isB) attn_block<0>(lds, Kb, Vb, 36, 0, qp, 1024, gp, 1024, op, 0.f, qt * 32, nullptr, 0);
            else {
                const int q0 = qt * 32;
                const int lo = max(0, q0 - 128) & ~63;
                const int hi = (min(SEQ, q0 + 160) + 63) & ~63;
                attn_block<1>(lds, Kb, Vb, 4 + ((hi - lo) >> 6), lo, qp, 1024, gp, 1024, op, p.b_sink[j * 8 + head] * LOG2E, q0, nullptr, 0);
            }
        } else {
            const int idx = item - 2048;
            const int b = idx >> 5, slot = (idx >> 3) & 3, qt = idx & 7;
            const bool isB = slot >= 2;
            const int head = (slot & 1) * 4 + w;
            const int col = (isB ? 512 : 0) + head * 64;
            const int r0 = b * TB + qt * 32;
            const bf16_t* Kb = p.kbuf + (size_t)(b * 4 + slot) * TB * 64;
            const bf16_t* Vb = p.vT + (size_t)(b * 4 + slot) * 64 * TB;
            const bf16_t* qp = p.qbuf + (size_t)r0 * 1024 + col;
            const bf16_t* gp = p.gbuf + (size_t)r0 * 1024 + col;
            bf16_t* op = p.h + (size_t)r0 * 1024 + col;
            if (!isB) attn_block<0>(lds, Kb, Vb, 4, 0, qp, 1024, gp, 1024, op, 0.f, 0, nullptr, 0);
            else attn_block<1>(lds, Kb, Vb, 4, 0, qp, 1024, gp, 1024, op, p.b_sink[j * 8 + head] * LOG2E, 0, nullptr, 0);
        }
    }
}

constexpr int CT = 16;
DI void conv_item(const Params& p, int j, int rbase  , int seglen, int t0, char* lds) {
    const int tid = otid(), lane = tid & 63, w = tid >> 6;
    const int c = 2 * tid;
    float wt[31][2];
    const float* wb = p.c_dw_w + (size_t)j * 31 * 512 + c;
    const bf16_t* cb = p.cbuf + (size_t)rbase * 1536 + c;
    asm volatile("" : "+v"(wb));
    asm volatile("" : "+v"(cb));
#pragma unroll
    for (int k = 0; k < 31; ++k) { const f32x2 v = *(const f32x2*)(wb + k * 512); wt[k][0] = v[0]; wt[k][1] = v[1]; }
    const f32x2 bias = *(const f32x2*)(p.c_dw_b + j * 512 + c);
    float acc[CT][2];
#pragma unroll
    for (int o = 0; o < CT; ++o) { acc[o][0] = bias[0]; acc[o][1] = bias[1]; }
#pragma unroll
    for (int i = 0; i < CT + 30; ++i) {
        const int pos = t0 - 15 + i;
        float u0 = 0.f, u1 = 0.f;
        if (pos >= 0 && pos < seglen) {
            const bf16_t* rp = cb + (ptrdiff_t)pos * 1536;
            const unsigned a = *(const unsigned*)rp, g = *(const unsigned*)(rp + 512);
            u0 = bf_lo(a) * sigmoid_f(bf_lo(g)); u1 = bf_hi(a) * sigmoid_f(bf_hi(g));
        }
#pragma unroll
        for (int o = 0; o < CT; ++o) {
            const int k = i - o;
            if (k >= 0 && k < 31) { acc[o][0] += wt[k][0] * u0; acc[o][1] += wt[k][1] * u1; }
        }
    }
    float* red = (float*)lds;
    float* stat = red + CT * 8;
    __syncthreads();
#pragma unroll
    for (int o = 0; o < CT; ++o) {
        float s1 = acc[o][0] + acc[o][1], s2 = acc[o][0] * acc[o][0] + acc[o][1] * acc[o][1];
#pragma unroll
        for (int sh = 32; sh >= 1; sh >>= 1) { s1 += __shfl_xor(s1, sh); s2 += __shfl_xor(s2, sh); }
        if (lane == 0) { red[(o * 4 + w) * 2] = s1; red[(o * 4 + w) * 2 + 1] = s2; }
    }
    __syncthreads();
    if (tid < CT) {
        float s1 = 0.f, s2 = 0.f;
#pragma unroll
        for (int q = 0; q < 4; ++q) { s1 += red[(tid * 4 + q) * 2]; s2 += red[(tid * 4 + q) * 2 + 1]; }
        const float mean = s1 * (1.0f / 512.0f);
        const float var = fmaxf(s2 * (1.0f / 512.0f) - mean * mean, 0.f);
        stat[tid * 2] = mean; stat[tid * 2 + 1] = rsqrtf(var + EPS);
    }
    __syncthreads();
    const f32x2 lg = *(const f32x2*)(p.c_ln_g + j * 512 + c), lb = *(const f32x2*)(p.c_ln_b + j * 512 + c);
#pragma unroll
    for (int o = 0; o < CT; ++o) {
        const f32x2 st = *(const f32x2*)(stat + 2 * o);
        const float mean = st[0], rstd = st[1];
        const size_t r = (size_t)(rbase + t0 + o);
        const unsigned sg = *(const unsigned*)(cb + (ptrdiff_t)(t0 + o) * 1536 + 1024);
        const float y0 = silu_f((acc[o][0] - mean) * rstd * lg[0] + lb[0]) * bf_lo(sg);
        const float y1 = silu_f((acc[o][1] - mean) * rstd * lg[1] + lb[1]) * bf_hi(sg);
        *(unsigned*)(p.h + r * 1024 + c) = pk2(y0, y1);
    }
}

DI void odd_mix_phase(const Params& p, int layer, char* lds, const Grp& g) {
    const int j = layer >> 1;
    const bool upd = layer < 3;
    const int tid = otid(), w = __builtin_amdgcn_readfirstlane(tid >> 6);
    constexpr int NCL = NB * SEQ / CT, NCC = NB * CTX / CT, I1 = 1024 + NCL, I2 = I1 + 128;
    const int total = I1 + (upd ? 128 + NCC : 0); (void)total;
    const int local = g.local, nlocal = g.nlocal;
    constexpr int PCL = NCL / NB, PCC = NCC / NB;
    const int per_b = 128 + PCL + (upd ? 16 + PCC : 0);
    float* rpb_lds = (float*)(lds + 3 * 16384) + 64;
    for (int xcd = g.xcd; xcd < NB; xcd += g.nx)
    for (int li = local; li < per_b; li += nlocal) {
        const int item = (li < 128) ? (xcd * 128 + li) : (li < 128 + PCL) ? (1024 + xcd * PCL + (li - 128)) : (li < 128 + PCL + 16) ? (I1 + xcd * 16 + (li - 128 - PCL)) : (I2 + xcd * PCC + (li - 128 - PCL - 16));
        if (item < 1024) {
            const int b = item >> 7, hd = (item >> 4) & 7, rp = item & 15;
            __syncthreads();
            for (int i = tid; i < 465 + 128; i += 256) { const int k = i - 64; rpb_lds[k] = (k >= 0 && k < 465) ? p.d_rpb[((size_t)j * 8 + hd) * 465 + k] : 0.f; }
            const int rq = 2 * rp + (w >> 1);
            const int lo_row = min(max(2 * rp - 4, 0), 24), hi_row = min(max(2 * rp + 1 - 4, 0), 24) + 8;
            const int tq0 = rq * 64 + (w & 1) * 32;
            const int r0 = b * TB + CTX + tq0;
            const bf16_t* Kb = p.kbuf + (size_t)(b * 8 + hd) * TB * 64;
            const bf16_t* Vb = p.vT + (size_t)(b * 8 + hd) * 64 * TB;
            attn_block<2>(lds, Kb, Vb, 4 + (hi_row - lo_row), lo_row * 64, p.qbuf + (size_t)r0 * 512 + hd * 64, 512, p.gbuf + (size_t)r0 * 512 + hd * 64, 512,
                          p.h + (size_t)r0 * 1024 + 512 + hd * 64, 0.f, tq0, rpb_lds, rq);
        } else if (item >= I1 && item < I2) {
            const int idx = item - I1, b = idx >> 4, hd = (idx >> 1) & 7, half = idx & 1;
            const int r0 = b * TB + half * 128 + w * 32;
            const bf16_t* Kb = p.kbuf + (size_t)(b * 8 + hd) * TB * 64;
            const bf16_t* Vb = p.vT + (size_t)(b * 8 + hd) * 64 * TB;
            attn_block<0>(lds, Kb, Vb, 4, 0, p.qbuf + (size_t)r0 * 512 + hd * 64, 512, p.gbuf + (size_t)r0 * 512 + hd * 64, 512,
                          p.h + (size_t)r0 * 1024 + 512 + hd * 64, 0.f, 0, nullptr, 0);
        } else {
            int rbase, seglen, t0;
            if (item < I1) { const int idx = item - 1024; rbase = (idx / (SEQ / CT)) * TB + CTX; seglen = SEQ; t0 = (idx % (SEQ / CT)) * CT; }
            else { const int idx = item - I2; rbase = (idx / (CTX / CT)) * TB; seglen = CTX; t0 = (idx % (CTX / CT)) * CT; }
            conv_item(p, j, rbase, seglen, t0, lds);
        }
    }
}

#ifndef PMASK
#define PMASK 0xff
#endif
DI void run_phase(const Params& p, int ph, char* lds, const Grp& g) {
    if (ph == 0) { phase0(p, lds); return; }
    if (ph == 17) { final_phase(p, g); return; }
    const int layer = (ph - 1) >> 2, sub = (ph - 1) & 3;
    if (sub == 0) norm_phase(p, layer, g);
    else if (sub == 1) gemm_in_phase(p, layer, lds, g);
    else if (sub == 2) { if (layer & 1) odd_mix_phase(p, layer, lds, g); else even_mix_phase(p, layer, lds, g); }
    else gemm_out_phase(p, layer, lds, g);
}

__global__ void __launch_bounds__(256, 2) fwd_kernel(Params p, int ph0, int ph1) {
    __shared__ __attribute__((aligned(16))) char lds[LDS_BYTES];
    __shared__ uint4 xb_words;
    XcdBarrier xb;
    const bool multi = (ph1 - ph0) > 1;
    Grp g; g.xcd = blockIdx.x & 7; g.local = blockIdx.x >> 3; g.nlocal = gridDim.x >> 3; g.nx = 8;
    if (multi) {
        if (threadIdx.x == 0) xb_words = make_uint4(0u, 0u, 0u, 0u);
        __syncthreads();
        xb = xcd_barrier_post(p.bar, (volatile LAS unsigned*)&xb_words);
    }
#ifdef CLOCK_PROBE
    const unsigned long long ct0 = __builtin_amdgcn_s_memtime(), cr0 = __builtin_amdgcn_s_memrealtime();
#endif
    for (int ph = ph0; ph < ph1; ++ph) {
        if (ph > ph0) {
            if (ph == ph0 + 1) {
                xcd_barrier(xb);
                g.nlocal = (int)xb.st[0]; g.nx = (int)xb.st[1]; g.xcd = (int)xb.st[2]; g.local = (int)xb.st[3];
            } else xcc_barrier(xb);
        }
        run_phase(p, ph, lds, g);
    }
#ifdef CLOCK_PROBE
    if (blockIdx.x == 0 && threadIdx.x == 0) {
        const unsigned long long ct1 = __builtin_amdgcn_s_memtime(), cr1 = __builtin_amdgcn_s_memrealtime();
        const unsigned long long mhz = (ct1 - ct0) * 100ull / (cr1 - cr0 + 1ull);
        const unsigned long long extra = mhz * 10ull;
        while (__builtin_amdgcn_s_memrealtime() - cr1 < extra) __builtin_amdgcn_s_sleep(8);
    }
#endif
}

extern "C" void kernel_launch(void* const* d_in, const int* in_sizes, int n_in, void* d_out, int out_size, void* d_ws, size_t ws_size, hipStream_t stream) {
    Params p{};
    p.x = (const float*)d_in[0]; p.c = (const float*)d_in[1]; p.ctx = (const float*)d_in[2]; p.c_ctx = (const float*)d_in[3];
    p.mod_w = (const float*)d_in[4]; p.mod_b = (const float*)d_in[5]; p.norm_g = (const float*)d_in[6];
    p.ev_w_in = (const float*)d_in[7]; p.ev_w_out = (const float*)d_in[8]; p.a_q_gain = (const float*)d_in[9]; p.a_k_gain = (const float*)d_in[10]; p.b_sink = (const float*)d_in[11];
    p.od_w_in = (const float*)d_in[12]; p.od_w_out = (const float*)d_in[13]; p.c_dw_w = (const float*)d_in[14]; p.c_dw_b = (const float*)d_in[15];
    p.c_ln_g = (const float*)d_in[16]; p.c_ln_b = (const float*)d_in[17]; p.d_rpb = (const float*)d_in[18]; p.final_g = (const float*)d_in[19];
    p.out = (float*)d_out;
    char* ws = (char*)d_ws; size_t off = 0;
    auto take = [&](size_t bytes) { char* r = ws + off; off += (bytes + 255) & ~(size_t)255; return r; };
    p.bar = (unsigned*)take(XCD_BAR_WORDS * 4);
    p.mvec = (float*)take((size_t)4 * 9 * 3072 * 4);
    p.rope = (float*)take((size_t)2048 * 64 * 4);
    p.wt_ev_in = (bf16_t*)take((size_t)2 * 2560 * 1024 * 2);
    p.wt_ev_out = (bf16_t*)take((size_t)2 * 1024 * 1024 * 2);
    p.wt_od_in = (bf16_t*)take((size_t)2 * 3584 * 1024 * 2);
    p.wt_od_out = (bf16_t*)take((size_t)2 * 1024 * 1024 * 2);
    p.xctx = (float*)take((size_t)NB * CTX * DM * 4);
    p.h = (bf16_t*)take((size_t)MROWS * 1024 * 2);
    p.qbuf = (bf16_t*)take((size_t)MROWS * 1024 * 2);
    p.gbuf = (bf16_t*)take((size_t)MROWS * 1024 * 2);
    p.cbuf = (bf16_t*)take((size_t)MROWS * 1536 * 2);
    p.kbuf = (bf16_t*)take((size_t)NB * 8 * TB * 64 * 2);
    p.vT = (bf16_t*)take((size_t)NB * 8 * 64 * TB * 2);
    if (off > ws_size) { fprintf(stderr, "workspace too small: need %zu have %zu\n", off, ws_size); return; }

    static int grid_blocks = 0;
    if (!grid_blocks) {
        int dev = 0, cus = 0, per_cu = 0;
        hipGetDevice(&dev);
        hipDeviceGetAttribute(&cus, hipDeviceAttributeMultiprocessorCount, dev);
        hipOccupancyMaxActiveBlocksPerMultiprocessor(&per_cu, fwd_kernel, 256, 0);
        if (per_cu > 2) per_cu = 2;
        if (per_cu < 1) per_cu = 1;
        grid_blocks = cus * per_cu;
        grid_blocks &= ~7;
    }
#if MULTI_LAUNCH
    for (int ph = 0; ph < 18; ++ph) hipLaunchKernelGGL(fwd_kernel, dim3(grid_blocks), dim3(256), 0, stream, p, ph, ph + 1);
#else
    hipMemsetAsync(p.bar, 0, XCD_BAR_WORDS * 4, stream);
    int ph0 = 0, ph1 = 18;
    void* args[] = {&p, &ph0, &ph1};
    hipError_t e = hipLaunchCooperativeKernel((void*)fwd_kernel, dim3(grid_blocks), dim3(256), args, 0, stream);
    if (e != hipSuccess) fprintf(stderr, "cooperative launch failed: %s (grid %d)\n", hipGetErrorString(e), grid_blocks);
#endif
}
```

```cpp
#include <hip/hip_runtime.h>
#include <hip/hip_cooperative_groups.h>
#include <cstdint>
#include <cstdio>

#ifndef MULTI_LAUNCH
#define MULTI_LAUNCH 0
#endif

#define DI __device__ __forceinline__
#define LAS __attribute__((address_space(3)))

typedef unsigned short bf16_t;
typedef short bf16x8 __attribute__((ext_vector_type(8)));
typedef float f32x16 __attribute__((ext_vector_type(16)));
typedef float f32x4 __attribute__((ext_vector_type(4)));
typedef float f32x2 __attribute__((ext_vector_type(2)));
typedef unsigned u32x4 __attribute__((ext_vector_type(4)));
typedef unsigned u32x2 __attribute__((ext_vector_type(2)));
typedef __bf16 bf16v2 __attribute__((ext_vector_type(2)));

constexpr int NB = 8, SEQ = 2048, DM = 1024, CTX = 256, TB = 2304, MROWS = NB * TB;
constexpr float EPS = 1e-6f, LOG2E = 1.4426950408889634f;
constexpr int LROW = 144;
constexpr int GT_BYTES = 128 * LROW;
constexpr int LDS_BYTES = 73728;

struct Params {
    const float *x, *c, *ctx, *c_ctx, *mod_w, *mod_b, *norm_g, *ev_w_in, *ev_w_out, *a_q_gain, *a_k_gain, *b_sink,
        *od_w_in, *od_w_out, *c_dw_w, *c_dw_b, *c_ln_g, *c_ln_b, *d_rpb, *final_g;
    float* out;
    unsigned* bar;
    float* mvec;
    float* rope;
    bf16_t *wt_ev_in, *wt_ev_out, *wt_od_in, *wt_od_out;
    float* xctx;
    bf16_t* h;
    bf16_t* qbuf;
    bf16_t* gbuf;
    bf16_t* cbuf;
    bf16_t* kbuf;
    bf16_t* vT;
};

DI unsigned pk2(float a, float b) { f32x2 v = {a, b}; bf16v2 r = __builtin_convertvector(v, bf16v2); return __builtin_bit_cast(unsigned, r); }
DI float bf_lo(unsigned u) { return __uint_as_float(u << 16); }
DI float bf_hi(unsigned u) { return __uint_as_float(u & 0xffff0000u); }
DI float silu_f(float x) { return x * __builtin_amdgcn_rcpf(1.f + __builtin_amdgcn_exp2f(-LOG2E * x)); }
DI float sigmoid_f(float x) { return __builtin_amdgcn_rcpf(1.f + __builtin_amdgcn_exp2f(-LOG2E * x)); }
DI int otid() { int t = threadIdx.x; asm volatile("" : "+v"(t)); return t; }
DI float max3f(float a, float b, float c) { float r; asm("v_max3_f32 %0, %1, %2, %3" : "=v"(r) : "v"(a), "v"(b), "v"(c)); return r; }
#define MFMA32(a, b, c) __builtin_amdgcn_mfma_f32_32x32x16_bf16((a), (b), (c), 0, 0, 0)

DI const float* res_in_row(const Params& p, int layer, int r) {
    const int b = r / TB, t = r - b * TB;
    if (t < CTX) return (layer == 0 ? p.ctx : (const float*)p.xctx) + (size_t)(b * CTX + t) * DM;
    return (layer == 0 ? p.x : (const float*)p.out) + (size_t)(b * SEQ + t - CTX) * DM;
}
DI float* res_out_row(const Params& p, int r) {
    const int b = r / TB, t = r - b * TB;
    if (t < CTX) return p.xctx + (size_t)(b * CTX + t) * DM;
    return p.out + (size_t)(b * SEQ + t - CTX) * DM;
}

#define XB_TMO      128
#define XB_XCNT(j)  (256  + 64 * (j))
#define XB_XSUB(j)  (1280 + 64 * (j))
#define XB_XGEN(j)  (2304 + 64 * (j))
#define XB_TOP      3328
#define XB_TOPGEN   3392
#define XB_LSUB(j)  (3456 + 64 * (j))
#define XB_LGEN(j)  (4480 + 64 * (j))
#define XCD_BAR_WORDS 5504
#define XB_SPIN_CAP (1u << 22)
DI unsigned xb_ld(unsigned* p) { return __hip_atomic_load(p, __ATOMIC_RELAXED, __HIP_MEMORY_SCOPE_AGENT); }
DI unsigned xb_add(unsigned* p, unsigned v) { return __hip_atomic_fetch_add(p, v, __ATOMIC_RELAXED, __HIP_MEMORY_SCOPE_AGENT); }
DI unsigned xb_xcc_id() { return (unsigned)__builtin_amdgcn_s_getreg((3 << 11) | 20) & 0xFu; }
#define XB_SPIN(cond, bar) do { unsigned _sp = 0; while (cond) { __builtin_amdgcn_s_sleep(1); \
    if ((++_sp & 255u) == 0u) { if (xb_ld(&(bar)[XB_TMO])) break; if (_sp > XB_SPIN_CAP) { atomicAdd(&(bar)[XB_TMO], 1u); break; } } } } while (0)
struct XcdBarrier { unsigned* bar; unsigned x; volatile LAS unsigned* st; };
DI XcdBarrier xcd_barrier_post(unsigned* bar, volatile LAS unsigned* st) {
    XcdBarrier b; b.bar = bar; b.x = xb_xcc_id(); b.st = st;
    if (threadIdx.x == 0) st[3] = xb_add(&bar[XB_XCNT(b.x)], 1u);
    return b;
}
DI void xcd_barrier_complete(unsigned* bar, unsigned x, unsigned& nloc, unsigned& nx, unsigned& xidx) {
    const unsigned G = gridDim.x * gridDim.y * gridDim.z;
    unsigned sum, cnt, mine, below, sp = 0u;
    for (;;) {
        sum = 0u; cnt = 0u; mine = 0u; below = 0u;
#pragma unroll
        for (unsigned j = 0; j < 16; ++j) { const unsigned c = xb_ld(&bar[XB_XCNT(j)]); sum += c; cnt += (c > 0u) ? 1u : 0u; mine = (j == x) ? c : mine; below += (c > 0u && j < x) ? 1u : 0u; }
        if (sum == G) break;
        __builtin_amdgcn_s_sleep(1);
        if ((++sp & 255u) == 0u) { if (xb_ld(&bar[XB_TMO])) break; if (sp > XB_SPIN_CAP) { atomicAdd(&bar[XB_TMO], 1u); break; } }
    }
    nloc = mine > 0u ? mine : 1u; nx = cnt > 0u ? cnt : 1u; xidx = below;
}
DI void xcd_barrier(const XcdBarrier& b) {
    asm volatile("s_waitcnt vmcnt(0)" ::: "memory");
    __syncthreads();
    if (threadIdx.x == 0) {
        unsigned* bar = b.bar;
        asm volatile("" : "+s"(bar));
        __builtin_amdgcn_s_waitcnt(0);
        unsigned nloc = b.st[0], nx = b.st[1];
        if (nloc == 0u) { unsigned xidx; xcd_barrier_complete(bar, b.x, nloc, nx, xidx); b.st[0] = nloc; b.st[1] = nx; b.st[2] = xidx; }
        const unsigned old = xb_add(&bar[XB_XSUB(b.x)], 1u);
        const unsigned gen = old / nloc;
        if (old + 1u == (gen + 1u) * nloc) {
            __builtin_amdgcn_fence(__ATOMIC_RELEASE, "agent");
            asm volatile("s_waitcnt vmcnt(0)" ::: "memory");
            const unsigned og = xb_add(&bar[XB_TOP], 1u);
            const unsigned tg = og / nx;
            if (og + 1u == (tg + 1u) * nx) xb_add(&bar[XB_TOPGEN], 1u);
            else XB_SPIN(xb_ld(&bar[XB_TOPGEN]) == tg, bar);
            __builtin_amdgcn_fence(__ATOMIC_ACQUIRE, "agent");
            xb_add(&bar[XB_XGEN(b.x)], 1u);
            asm volatile("s_waitcnt vmcnt(0)" ::: "memory");
        } else {
            XB_SPIN(xb_ld(&bar[XB_XGEN(b.x)]) == gen, bar);
            __builtin_amdgcn_fence(__ATOMIC_ACQUIRE, "agent");
            asm volatile("s_waitcnt vmcnt(0)" ::: "memory");
        }
    }
    __syncthreads();
}

DI void xcc_barrier(const XcdBarrier& b) {
    asm volatile("s_waitcnt vmcnt(0)" ::: "memory");
    __syncthreads();
    if (threadIdx.x == 0) {
        unsigned* bar = b.bar;
        asm volatile("" : "+s"(bar));
        __builtin_amdgcn_s_waitcnt(0);
        const unsigned nloc = b.st[0];
        const unsigned old = xb_add(&bar[XB_LSUB(b.x)], 1u);
        const unsigned gen = old / nloc;
        if (old + 1u == (gen + 1u) * nloc) xb_add(&bar[XB_LGEN(b.x)], 1u);
        else XB_SPIN(xb_ld(&bar[XB_LGEN(b.x)]) == gen, bar);
        __builtin_amdgcn_fence(__ATOMIC_ACQUIRE, "agent");
        asm volatile("s_waitcnt vmcnt(0)" ::: "memory");
    }
    __syncthreads();
}

struct Grp { int xcd, local, nlocal, nx; };

DI void mod_item(const Params& p, char* lds, int item) {
    const int tid = otid();
    const int layer = item / 48, n0 = (item % 48) * 64;
    float* sc = (float*)lds;
    float* part = (float*)(lds + 36864);
    __syncthreads();
    for (int i = tid; i < 9 * 1024; i += 256) { const int j = i >> 10, k = i & 1023; const float v = (j < 8) ? p.c[j * 1024 + k] : p.c_ctx[k]; sc[i] = silu_f(v); }
    __syncthreads();
    const int kg = tid >> 4, c4 = (tid & 15) * 4;
    f32x4 acc[9];
#pragma unroll
    for (int j = 0; j < 9; ++j) acc[j] = (f32x4){0.f, 0.f, 0.f, 0.f};
    const float* wp = p.mod_w + ((size_t)layer * 1024 + kg * 64) * 3072 + n0 + c4;
    const float* scp = sc + kg * 64;
#pragma unroll 16
    for (int k = 0; k < 64; ++k) {
        const f32x4 wv = *(const f32x4*)(wp + (size_t)k * 3072);
#pragma unroll
        for (int j = 0; j < 9; ++j) { const float sv = scp[j * 1024 + k]; acc[j] += wv * sv; }
    }
#pragma unroll
    for (int j = 0; j < 9; ++j) *(f32x4*)(part + (kg * 9 + j) * 64 + c4) = acc[j];
    __syncthreads();
    for (int i = tid; i < 9 * 64; i += 256) {
        const int j = i >> 6, cc = i & 63;
        float sm = p.mod_b[layer * 3072 + n0 + cc];
#pragma unroll
        for (int g = 0; g < 16; ++g) sm += part[(g * 9 + j) * 64 + cc];
        p.mvec[((size_t)layer * 9 + j) * 3072 + n0 + cc] = sm;
    }
}

DI void rope_item(const Params& p, int item) {
    const int idx = item * 256 + otid();
    const int t = idx >> 5, pp = idx & 31;
    const float pos = (float)((pp < 16) ? (t >> 6) : (t & 63));
    const float freq = powf(10000.0f, -(float)(pp & 15) / 16.0f);
    const float ang = pos * freq;
    float sn, cs; sincosf(ang, &sn, &cs);
    *(f32x2*)(p.rope + (size_t)idx * 2) = (f32x2){cs, sn};
}

DI void wconv_item(const float* __restrict__ W, bf16_t* __restrict__ Wt, int N, int tile, char* lds) {
    const int tid = otid();
    const int ntn = N >> 6, kt = tile / ntn, nt_ = tile - kt * ntn, k0 = kt * 64, n0 = nt_ * 64;
    float* tl = (float*)lds;
    __syncthreads();
#pragma unroll
    for (int j = 0; j < 4; ++j) {
        const int kk = (tid >> 4) + 16 * j, nn = (tid & 15) * 4;
        const f32x4 v = *(const f32x4*)(W + (size_t)(k0 + kk) * N + n0 + nn);
        tl[kk * 65 + nn + 0] = v[0]; tl[kk * 65 + nn + 1] = v[1]; tl[kk * 65 + nn + 2] = v[2]; tl[kk * 65 + nn + 3] = v[3];
    }
    __syncthreads();
#pragma unroll
    for (int j = 0; j < 2; ++j) {
        const int idx = tid + 256 * j, n = idx >> 3, kc = (idx & 7) * 8;
        u32x4 o;
        o[0] = pk2(tl[(kc + 0) * 65 + n], tl[(kc + 1) * 65 + n]);
        o[1] = pk2(tl[(kc + 2) * 65 + n], tl[(kc + 3) * 65 + n]);
        o[2] = pk2(tl[(kc + 4) * 65 + n], tl[(kc + 5) * 65 + n]);
        o[3] = pk2(tl[(kc + 6) * 65 + n], tl[(kc + 7) * 65 + n]);
        *(u32x4*)(Wt + (size_t)(n0 + n) * 1024 + k0 + kc) = o;
    }
}

DI void phase0(const Params& p, char* lds) {
    const int total = 192 + 256 + 4096;
    for (int item = blockIdx.x; item < total; item += gridDim.x) {
        if (item < 192) mod_item(p, lds, item);
        else if (item < 448) rope_item(p, item - 192);
        else {
            int w = item - 448; const int j = w >> 11; w &= 2047;
            if (w < 640) wconv_item(p.ev_w_in + (size_t)j * 1024 * 2560, p.wt_ev_in + (size_t)j * 2560 * 1024, 2560, w, lds);
            else if (w < 896) wconv_item(p.ev_w_out + (size_t)j * 1024 * 1024, p.wt_ev_out + (size_t)j * 1024 * 1024, 1024, w - 640, lds);
            else if (w < 1792) wconv_item(p.od_w_in + (size_t)j * 1024 * 3584, p.wt_od_in + (size_t)j * 3584 * 1024, 3584, w - 896, lds);
            else wconv_item(p.od_w_out + (size_t)j * 1024 * 1024, p.wt_od_out + (size_t)j * 1024 * 1024, 1024, w - 1792, lds);
        }
    }
}

DI void norm_phase(const Params& p, int layer, const Grp& grp) {
    const int lane = otid() & 63, w = otid() >> 6;
    const float* g = p.norm_g + layer * 1024;
    const int local = grp.local, nlocal = grp.nlocal;
    for (int xcd = grp.xcd; xcd < NB; xcd += grp.nx)
#pragma unroll 1
        for (int seg = 0; seg < 2; ++seg) {
            const int cond = seg ? xcd : 8;
            const float* mv = p.mvec + ((size_t)layer * 9 + cond) * 3072;
            f32x4 mul[4], add[4];
#pragma unroll
            for (int j = 0; j < 4; ++j) {
                const int c0 = lane * 4 + 256 * j;
                const f32x4 gg = *(const f32x4*)(g + c0), sh = *(const f32x4*)(mv + c0), sc = *(const f32x4*)(mv + 1024 + c0);
#pragma unroll
                for (int e = 0; e < 4; ++e) { mul[j][e] = gg[e] * (1.f + sc[e]); add[j][e] = sh[e]; }
            }
            const int i0 = seg ? CTX / 4 : 0, i1 = seg ? TB / 4 : CTX / 4;
            for (int li = i0 + local; li < i1; li += nlocal) {
                const int r = (xcd * (TB / 4) + li) * 4 + w;
                const float* xr = res_in_row(p, layer, r);
                f32x4 v[4]; float ss = 0.f;
#pragma unroll
                for (int j = 0; j < 4; ++j) { v[j] = *(const f32x4*)(xr + lane * 4 + 256 * j); ss += v[j][0] * v[j][0] + v[j][1] * v[j][1] + v[j][2] * v[j][2] + v[j][3] * v[j][3]; }
#pragma unroll
                for (int o = 32; o >= 1; o >>= 1) ss += __shfl_xor(ss, o);
                const float rstd = rsqrtf(ss * (1.0f / 1024.0f) + EPS);
                bf16_t* hr = p.h + (size_t)r * 1024;
#pragma unroll
                for (int j = 0; j < 4; ++j) {
                    const int c0 = lane * 4 + 256 * j;
                    float y[4];
#pragma unroll
                    for (int e = 0; e < 4; ++e) y[e] = (v[j][e] * rstd) * mul[j][e] + add[j][e];
                    *(u32x2*)(hr + c0) = (u32x2){pk2(y[0], y[1]), pk2(y[2], y[3])};
                }
            }
        }
}

DI void final_phase(const Params& p, const Grp& g) {
    const int lane = otid() & 63, w = otid() >> 6;
    const int local = g.local, nlocal = g.nlocal;
    f32x4 fg[4];
#pragma unroll
    for (int j = 0; j < 4; ++j) fg[j] = *(const f32x4*)(p.final_g + lane * 4 + 256 * j);
    for (int xcd = g.xcd; xcd < NB; xcd += g.nx)
    for (int li = local; li < SEQ / 4; li += nlocal) {
        const int item = xcd * (SEQ / 4) + li;
        const int r = item * 4 + w;
        float* xr = p.out + (size_t)r * 1024;
        f32x4 v[4]; float ss = 0.f;
#pragma unroll
        for (int j = 0; j < 4; ++j) { v[j] = *(const f32x4*)(xr + lane * 4 + 256 * j); ss += v[j][0] * v[j][0] + v[j][1] * v[j][1] + v[j][2] * v[j][2] + v[j][3] * v[j][3]; }
#pragma unroll
        for (int o = 32; o >= 1; o >>= 1) ss += __shfl_xor(ss, o);
        const float rstd = rsqrtf(ss * (1.0f / 1024.0f) + EPS);
#pragma unroll
        for (int j = 0; j < 4; ++j) {
            const int c0 = lane * 4 + 256 * j;
            f32x4 o;
#pragma unroll
            for (int e = 0; e < 4; ++e) o[e] = v[j][e] * rstd * fg[j][e];
            *(f32x4*)(xr + c0) = o;
        }
    }
}

DI void dma16(const void* gsrc, unsigned lds_dst) { unsigned keep;
    asm volatile("s_mov_b32 %0, m0\n\ts_mov_b32 m0, %2\n\ts_nop 0\n\tglobal_load_lds_dwordx4 %1, off\n\ts_mov_b32 m0, %0" : "=&s"(keep) : "v"(gsrc), "s"(lds_dst) : "memory"); }
DI void dma16s(const void* base, unsigned voff, unsigned lds_dst) { unsigned keep;
    asm volatile("s_mov_b32 %0, m0\n\ts_mov_b32 m0, %3\n\ts_nop 0\n\tglobal_load_lds_dwordx4 %1, %2\n\ts_mov_b32 m0, %0" : "=&s"(keep) : "v"(voff), "s"(base), "s"(lds_dst) : "memory"); }
#define WAIT_BAR(N) asm volatile("s_waitcnt vmcnt(" #N ") lgkmcnt(0)\n\ts_barrier" ::: "memory")
#define WAIT_VM(n) asm volatile("s_waitcnt vmcnt(" #n ")" ::: "memory")

template <bool SWAP, int TI, int GP = 0>
DI void gemm_mainloop(const bf16_t* __restrict__ A, const bf16_t* __restrict__ W, int row0, int col0, f32x16 (&acc)[2 * TI], char* lds, bool pre_issued) {
    constexpr int MT = 64 * TI, STAGE = (MT + 128) * 64, NST = (TI == 4) ? 3 : 4, NA = TI, KT = 32;
    const int tid = otid(), lane = tid & 63, w = __builtin_amdgcn_readfirstlane(tid >> 6), wm = w >> 1, wn = w & 1, l31 = lane & 31, hh = lane >> 5;
    const int cc = (lane & 3) ^ ((lane >> 4) & 3);
    const unsigned pa = (unsigned)(((row0 + 16 * w + (lane >> 2)) * 1024 + cc * 8) * 2);
    const unsigned pb = (unsigned)(((col0 + 16 * w + (lane >> 2)) * 1024 + cc * 8) * 2);
    const unsigned l3 = (unsigned)(size_t)lds + w * 1024;
    const int sw = (l31 >> 2) & 3;
    const char* fa = lds + (wm * (32 * TI) + l31) * 64;
    const char* fb = lds + MT * 64 + (wn * 64 + l31) * 64;
    const int ch0 = ((0 + hh) ^ sw) * 16, ch1 = ((2 + hh) ^ sw) * 16;
#pragma unroll
    for (int i = 0; i < 2 * TI; ++i)
#pragma unroll
        for (int e = 0; e < 16; ++e) acc[i][e] = 0.f;
    if (!pre_issued) WAIT_BAR(0);
#define GEMM_ISSUE(kt, st) do { const unsigned _sb = l3 + (st) * STAGE; const int _ko = (kt) * 32; \
        _Pragma("unroll") for (int _j = 0; _j < NA; ++_j) dma16s(A, pa + (_j * 64 * 1024 + _ko) * 2, _sb + _j * 4096); \
        _Pragma("unroll") for (int _j = 0; _j < 2; ++_j) dma16s(W, pb + (_j * 64 * 1024 + _ko) * 2, _sb + MT * 64 + _j * 4096); } while (0)
#define GEMM_STAGE(DO_ISSUE, ktn) do { \
        const char* sa = fa + rs * STAGE; const char* sb = fb + rs * STAGE; \
        const unsigned _sbase = l3 + is * STAGE; const int _ko = (ktn) * 32; \
        bf16x8 af[2][TI], bf[2][2]; \
        _Pragma("unroll") for (int ks = 0; ks < 2; ++ks) { const int ch = ks ? ch1 : ch0; \
            _Pragma("unroll") for (int i = 0; i < TI; ++i) af[ks][i] = *(const bf16x8*)(sa + i * 32 * 64 + ch); \
            _Pragma("unroll") for (int j = 0; j < 2; ++j) bf[ks][j] = *(const bf16x8*)(sb + j * 32 * 64 + ch); } \
        _Pragma("unroll") for (int m = 0; m < 4 * TI; ++m) { \
            const int ks = m / (2 * TI), i = (m % (2 * TI)) >> 1, j = m & 1; \
            if (SWAP) acc[i * 2 + j] = MFMA32(af[ks][i], bf[ks][j], acc[i * 2 + j]); \
            else      acc[j * TI + i] = MFMA32(bf[ks][j], af[ks][i], acc[j * TI + i]); \
            if (DO_ISSUE && (m & 1) && (m >> 1) < NA + 2) { const int q = m >> 1; \
                __builtin_amdgcn_sched_barrier(0); \
                if (q < NA) dma16s(A, pa + (q * 64 * 1024 + _ko) * 2, _sbase + q * 4096); \
                else dma16s(W, pb + ((q - NA) * 64 * 1024 + _ko) * 2, _sbase + MT * 64 + (q - NA) * 4096); \
                __builtin_amdgcn_sched_barrier(0); } } \
        rs = (rs + 1 == NST) ? 0 : rs + 1; } while (0)
    if (TI == 2) {
        if (!pre_issued) { GEMM_ISSUE(0, 0); GEMM_ISSUE(1, 1); }
        int rs = 0, is = 2;
#pragma unroll 1
        for (int kp = 0; kp < KT / 2 - 1; ++kp) {
            WAIT_BAR(0);
            GEMM_STAGE(true, 2 * kp + 2);
            is = (is + 1) & 3;
            GEMM_STAGE(true, 2 * kp + 3);
            is = (is + 1) & 3;
        }
        WAIT_BAR(0);
        GEMM_STAGE(false, 0);
        GEMM_STAGE(false, 0);
    } else {
    if (!pre_issued) {
#pragma unroll
        for (int s = 0; s < NST - 1; ++s) GEMM_ISSUE(s, s);
    }
    int rs = 0, is = NST - 1;
#pragma unroll 1
    for (int kt = 0; kt < KT - (NST - 1); ++kt) {
        if (TI == 4) WAIT_BAR(6); else WAIT_BAR(8);
        GEMM_STAGE(true, kt + NST - 1);
        is = (is + 1 == NST) ? 0 : is + 1;
    }
#pragma unroll 1
    for (int kt = KT - (NST - 1); kt < KT; ++kt) {
        WAIT_BAR(0);
        GEMM_STAGE(false, 0);
    }
    }
#undef GEMM_STAGE
#undef GEMM_ISSUE
}

template <int TI>
DI void gemm_prefetch(const bf16_t* __restrict__ A, const bf16_t* __restrict__ W, int row0, int col0, char* lds) {
    constexpr int MT = 64 * TI, STAGE = (MT + 128) * 64, NST = (TI == 4) ? 3 : 4, NA = TI;
    const int tid = otid(), lane = tid & 63, w = __builtin_amdgcn_readfirstlane(tid >> 6);
    const int cc = (lane & 3) ^ ((lane >> 4) & 3);
    const unsigned pa = (unsigned)(((row0 + 16 * w + (lane >> 2)) * 1024 + cc * 8) * 2);
    const unsigned pb = (unsigned)(((col0 + 16 * w + (lane >> 2)) * 1024 + cc * 8) * 2);
    const unsigned l3 = (unsigned)(size_t)lds + w * 1024;
    asm volatile("s_waitcnt lgkmcnt(0)\n\ts_barrier" ::: "memory");
#pragma unroll
    for (int s = 0; s < ((TI == 2) ? 2 : NST - 1); ++s) {
        const unsigned sb = l3 + s * STAGE; const int ko = s * 32;
#pragma unroll
        for (int j = 0; j < NA; ++j) dma16s(A, pa + (j * 64 * 1024 + ko) * 2, sb + j * 4096);
#pragma unroll
        for (int j = 0; j < 2; ++j) dma16s(W, pb + (j * 64 * 1024 + ko) * 2, sb + MT * 64 + j * 4096);
    }
}

DI void store_pair16(bf16_t* pairp  , int hh, unsigned a0, unsigned a1, unsigned b0, unsigned b1) {
    const u32x2 r0 = __builtin_amdgcn_permlane32_swap(a0, b0, false, false);
    const u32x2 r1 = __builtin_amdgcn_permlane32_swap(a1, b1, false, false);
    *(u32x4*)(pairp + 8 * hh) = (u32x4){r0[0], r1[0], r0[1], r1[1]};
}

template <int TR, int TI>
DI void epi_plain(const f32x16 (&acc)[2 * TI], bf16_t* dst, int stride, int row0) {
    const int lane = otid() & 63, w = __builtin_amdgcn_readfirstlane(otid() >> 6), wm = w >> 1, l31 = lane & 31, hh = lane >> 5;
#pragma unroll
    for (int ti = 0; ti < TI; ++ti) {
        const int r = row0 + wm * (32 * TI) + 32 * ti + l31;
        bf16_t* rp = dst + (size_t)r * stride;
#pragma unroll
        for (int fi = 0; fi < 2; ++fi)
#pragma unroll
            for (int gp = 0; gp < 2; ++gp) {
                float v[8];
#pragma unroll
                for (int e = 0; e < 8; ++e) { float x = acc[fi * TI + ti][8 * gp + e]; if (TR == 1) x = silu_f(x); if (TR == 2) x *= 0.125f; v[e] = x; }
                store_pair16(rp + 32 * fi + 16 * gp, hh, pk2(v[0], v[1]), pk2(v[2], v[3]), pk2(v[4], v[5]), pk2(v[6], v[7]));
            }
    }
}

template <bool RMS, bool ISQ, int TI>
DI void epi_qk(const Params& p, const f32x16 (&acc)[2 * TI], const float* gain, int row0, bf16_t* qdst  , int kslot, int nkv) {
    const int lane = otid() & 63, w = __builtin_amdgcn_readfirstlane(otid() >> 6), wm = w >> 1, l31 = lane & 31, hh = lane >> 5;
#pragma unroll
    for (int ti = 0; ti < TI; ++ti) {
        const int r = row0 + wm * (32 * TI) + 32 * ti + l31;
        const int b = r / TB, t = r - b * TB;
        float v[2][16];
#pragma unroll
        for (int fi = 0; fi < 2; ++fi)
#pragma unroll
            for (int e = 0; e < 16; ++e) v[fi][e] = acc[fi * TI + ti][e];
        if (RMS) {
            float ss = 0.f;
#pragma unroll
            for (int fi = 0; fi < 2; ++fi)
#pragma unroll
                for (int e = 0; e < 16; ++e) ss += v[fi][e] * v[fi][e];
            ss += __shfl_xor(ss, 32);
            const float rstd = rsqrtf(ss * (1.0f / 64.0f) + EPS);
#pragma unroll
            for (int fi = 0; fi < 2; ++fi)
#pragma unroll
                for (int g = 0; g < 4; ++g) {
                    const f32x4 gg = *(const f32x4*)(gain + 32 * fi + 8 * g + 4 * hh);
#pragma unroll
                    for (int e = 0; e < 4; ++e) v[fi][4 * g + e] = v[fi][4 * g + e] * rstd * gg[e];
                }
        }
        if (t >= CTX) {
            const float* rt = p.rope + (size_t)(t - CTX) * 64;
#pragma unroll
            for (int fi = 0; fi < 2; ++fi)
#pragma unroll
                for (int g = 0; g < 4; ++g) {
                    const f32x4 cs = *(const f32x4*)(rt + (16 * fi + 4 * g + 2 * hh) * 2);
                    const float x0 = v[fi][4 * g + 0], x1 = v[fi][4 * g + 1], x2 = v[fi][4 * g + 2], x3 = v[fi][4 * g + 3];
                    v[fi][4 * g + 0] = x0 * cs[0] - x1 * cs[1];
                    v[fi][4 * g + 1] = x0 * cs[1] + x1 * cs[0];
                    v[fi][4 * g + 2] = x2 * cs[2] - x3 * cs[3];
                    v[fi][4 * g + 3] = x2 * cs[3] + x3 * cs[2];
                }
        }
        bf16_t* rp = ISQ ? (qdst + (size_t)r * 1024) : (p.kbuf + ((size_t)(b * nkv + kslot) * TB + t) * 64);
#pragma unroll
        for (int fi = 0; fi < 2; ++fi)
#pragma unroll
            for (int gp = 0; gp < 2; ++gp) {
                float o[8];
#pragma unroll
                for (int e = 0; e < 8; ++e) o[e] = ISQ ? v[fi][8 * gp + e] * 0.125f : v[fi][8 * gp + e];
                store_pair16(rp + 32 * fi + 16 * gp, hh, pk2(o[0], o[1]), pk2(o[2], o[3]), pk2(o[4], o[5]), pk2(o[6], o[7]));
            }
    }
}

template <int TI>
DI void epi_k_plain(const Params& p, const f32x16 (&acc)[2 * TI], int row0, int kslot, int nkv) {
    const int lane = otid() & 63, w = __builtin_amdgcn_readfirstlane(otid() >> 6), wm = w >> 1, l31 = lane & 31, hh = lane >> 5;
#pragma unroll
    for (int ti = 0; ti < TI; ++ti) {
        const int r = row0 + wm * (32 * TI) + 32 * ti + l31;
        const int b = r / TB, t = r - b * TB;
        bf16_t* rp = p.kbuf + ((size_t)(b * nkv + kslot) * TB + t) * 64;
#pragma unroll
        for (int fi = 0; fi < 2; ++fi)
#pragma unroll
            for (int gp = 0; gp < 2; ++gp)
                store_pair16(rp + 32 * fi + 16 * gp, hh, pk2(acc[fi * TI + ti][8 * gp], acc[fi * TI + ti][8 * gp + 1]), pk2(acc[fi * TI + ti][8 * gp + 2], acc[fi * TI + ti][8 * gp + 3]),
                             pk2(acc[fi * TI + ti][8 * gp + 4], acc[fi * TI + ti][8 * gp + 5]), pk2(acc[fi * TI + ti][8 * gp + 6], acc[fi * TI + ti][8 * gp + 7]));
    }
}

template <int TI>
DI void epi_v(const Params& p, const f32x16 (&acc)[2 * TI], int row0, int vslot, int nkv) {
    const int lane = otid() & 63, w = __builtin_amdgcn_readfirstlane(otid() >> 6), wm = w >> 1, l31 = lane & 31, hh = lane >> 5;
#pragma unroll
    for (int ti = 0; ti < TI; ++ti) {
        const int rb = row0 + wm * (32 * TI) + 32 * ti;
        const int b = rb / TB, tb = rb - b * TB;
#pragma unroll
        for (int fi = 0; fi < 2; ++fi) {
            const int d = 32 * fi + l31;
            bf16_t* vp = p.vT + ((size_t)(b * nkv + vslot) * 64 + d) * TB + tb;
#pragma unroll
            for (int gq = 0; gq < 2; ++gq) {
                u32x4 o;
                o[0] = pk2(acc[ti * 2 + fi][8 * gq + 0], acc[ti * 2 + fi][8 * gq + 1]);
                o[1] = pk2(acc[ti * 2 + fi][8 * gq + 2], acc[ti * 2 + fi][8 * gq + 3]);
                o[2] = pk2(acc[ti * 2 + fi][8 * gq + 4], acc[ti * 2 + fi][8 * gq + 5]);
                o[3] = pk2(acc[ti * 2 + fi][8 * gq + 6], acc[ti * 2 + fi][8 * gq + 7]);
                *(u32x4*)(vp + 16 * gq + 8 * hh) = o;
            }
        }
    }
}

#ifndef GPROBE
#define GPROBE 0
#endif
constexpr int TIN = 4;
DI void gemm_in_phase(const Params& p, int layer, char* lds, const Grp& g, bool do_epi = true) {
    const bool even = (layer & 1) == 0;
    const int j = layer >> 1;
    const int N = even ? 2560 : 3584, nct = N / 128;
    const bf16_t* W = even ? p.wt_ev_in + (size_t)j * 2560 * 1024 : p.wt_od_in + (size_t)j * 3584 * 1024;
    const bool last = (layer == 3);
    const int local = g.local, nlocal = g.nlocal;
    const int wn = __builtin_amdgcn_readfirstlane(otid() >> 6) & 1;
    constexpr int RT_PER_XCD = MROWS / (64 * TIN) / 8;
    const int nli = RT_PER_XCD * nct;
#define GIN_SKIP(li_) (last && ((li_) / nct == 0) && ((((li_) % nct) * 128 < 2048) || (((li_) % nct) * 128 >= 3072)))
    for (int xcd = g.xcd; xcd < NB; xcd += g.nx) {
    int li = local;
    while (li < nli && GIN_SKIP(li)) li += nlocal;
    bool pre = false;
    while (li < nli) {
        const int rtl = li / nct, ct = li - rtl * nct;
        const int rt = xcd * RT_PER_XCD + rtl;
        const int row0 = rt * (64 * TIN), col0 = ct * 128;
        const int c64 = col0 + wn * 64;
        const bool swap = even ? (col0 == 640 || col0 == 1920) : (col0 >= 2560 && col0 < 3072);
        f32x16 acc[2 * TIN];
        if (!do_epi) {
            gemm_mainloop<false, TIN, GPROBE>(p.h, W, row0, col0, acc, lds, false);
            float sm = 0.f;
#pragma unroll
            for (int i = 0; i < 2 * TIN; ++i)
#pragma unroll
                for (int e = 0; e < 16; ++e) sm += acc[i][e];
            if (sm == 12345.678f) p.mvec[0] = sm;
            li += nlocal;
            continue;
        }
        if (swap) gemm_mainloop<true, TIN>(p.h, W, row0, col0, acc, lds, pre);
        else gemm_mainloop<false, TIN>(p.h, W, row0, col0, acc, lds, pre);
        int ln = li + nlocal;
        while (ln < nli && GIN_SKIP(ln)) ln += nlocal;
        pre = ln < nli;
        if (pre) { const int rtl2 = ln / nct, ct2 = ln - rtl2 * nct; gemm_prefetch<TIN>(p.h, W, (xcd * RT_PER_XCD + rtl2) * (64 * TIN), ct2 * 128, lds); }
        li = ln;
        if (even) {
            if (swap) epi_v<TIN>(p, acc, row0, (col0 == 640 ? 0 : 2) + wn, 4);
            else if (col0 < 512) epi_qk<true, true, TIN>(p, acc, p.a_q_gain + j * 64, row0, p.qbuf + c64, 0, 4);
            else if (col0 < 640) epi_qk<true, false, TIN>(p, acc, p.a_k_gain + j * 64, row0, nullptr, wn, 4);
            else if (col0 < 1280) epi_plain<1, TIN>(acc, p.gbuf + (c64 - 768), 1024, row0);
            else if (col0 < 1792) epi_qk<false, true, TIN>(p, acc, nullptr, row0, p.qbuf + 512 + (c64 - 1280), 0, 4);
            else if (col0 < 1920) epi_qk<false, false, TIN>(p, acc, nullptr, row0, nullptr, 2 + wn, 4);
            else epi_plain<1, TIN>(acc, p.gbuf + 512 + (c64 - 2048), 1024, row0);
        } else {
            if (swap) epi_v<TIN>(p, acc, row0, (c64 - 2560) >> 6, 8);
            else if (col0 < 1024) epi_plain<0, TIN>(acc, p.cbuf + c64, 1536, row0);
            else if (col0 < 1536) epi_plain<1, TIN>(acc, p.cbuf + c64, 1536, row0);
            else if (col0 < 2048) epi_plain<2, TIN>(acc, p.qbuf + (c64 - 1536), 512, row0);
            else if (col0 < 2560) epi_k_plain<TIN>(p, acc, row0, (c64 - 2048) >> 6, 8);
            else epi_plain<1, TIN>(acc, p.gbuf + (c64 - 3072), 512, row0);
        }
    }
    }
#undef GIN_SKIP
}

constexpr int TOUT = 2;
DI void gemm_out_phase(const Params& p, int layer, char* lds, const Grp& g) {
    const bool even = (layer & 1) == 0;
    const int j = layer >> 1;
    const bf16_t* W = (even ? p.wt_ev_out : p.wt_od_out) + (size_t)j * 1024 * 1024;
    const bool last = (layer == 3);
    const int local = g.local, nlocal = g.nlocal;
    constexpr int RT_PER_XCD = MROWS / (64 * TOUT) / 8;
    const int nli = RT_PER_XCD * 8;
#define GOUT_SKIP(li_) (last && ((li_) >> 3) < 2)
    for (int xcd = g.xcd; xcd < NB; xcd += g.nx) {
    int li = local;
    while (li < nli && GOUT_SKIP(li)) li += nlocal;
    bool pre = false;
    while (li < nli) {
        const int rtl = li >> 3, ct = li & 7;
        const int rt = xcd * RT_PER_XCD + rtl;
        const int row0 = rt * (64 * TOUT), col0 = ct * 128;
        f32x16 acc[2 * TOUT];
        gemm_mainloop<false, TOUT>(p.h  , W, row0, col0, acc, lds, pre);
        int ln = li + nlocal;
        while (ln < nli && GOUT_SKIP(ln)) ln += nlocal;
        pre = ln < nli;
        if (pre) gemm_prefetch<TOUT>(p.h, W, (xcd * RT_PER_XCD + (ln >> 3)) * (64 * TOUT), (ln & 7) * 128, lds);
        li = ln;
        const int lane = otid() & 63, w = __builtin_amdgcn_readfirstlane(otid() >> 6), wm = w >> 1, wn = w & 1, l31 = lane & 31, hh = lane >> 5;
#pragma unroll
        for (int ti = 0; ti < TOUT; ++ti) {
            const int r = row0 + wm * (32 * TOUT) + 32 * ti + l31;
            const int b = r / TB, t = r - b * TB;
            const int cond = (t < CTX) ? 8 : b;
            const float* gm = p.mvec + ((size_t)layer * 9 + cond) * 3072 + 2048;
            const float* xi = res_in_row(p, layer, r);
            float* xo = res_out_row(p, r);
#pragma unroll
            for (int fi = 0; fi < 2; ++fi)
#pragma unroll
                for (int g = 0; g < 4; ++g) {
                    const int c = col0 + wn * 64 + 32 * fi + 8 * g + 4 * hh;
                    const f32x4 xv = *(const f32x4*)(xi + c), gv = *(const f32x4*)(gm + c);
                    f32x4 o;
#pragma unroll
                    for (int e = 0; e < 4; ++e) o[e] = xv[e] + gv[e] * acc[fi * TOUT + ti][4 * g + e];
                    *(f32x4*)(xo + c) = o;
                }
        }
    }
    }
#undef GOUT_SKIP
}

template <int MODE>
DI void attn_block(char* lds, const bf16_t* __restrict__ Kb, const bf16_t* __restrict__ Vb, int nt, int lat_lo,
                   const bf16_t* __restrict__ qptr, int qstride, const bf16_t* __restrict__ gptr, int gstride, bf16_t* __restrict__ optr,
                   float sink_l2, int tq_base, const float* rpb_lds, int rq) {
    constexpr int ASTAGE = 16384;
    const int tid = otid(), lane = tid & 63, w = __builtin_amdgcn_readfirstlane(tid >> 6), l31 = lane & 31, hh = lane >> 5;
    const int r8 = lane >> 3;
    const int cc = (lane & 7) ^ (4 * (w & 1) + (r8 >> 1));
    const unsigned kp = (unsigned)(((8 * w + r8) * 64 + cc * 8) * 2);
    const unsigned vp = (unsigned)(((8 * w + r8) * TB + cc * 8) * 2);
    const unsigned l3 = (unsigned)(size_t)lds + w * 1024;
#define ATT_ISSUE(itile, st) do { const int _t0 = ((itile) < 4) ? (itile) * 64 : CTX + lat_lo + ((itile) - 4) * 64; const unsigned _sb = l3 + (st) * ASTAGE; \
        dma16s(Kb, kp + _t0 * 128, _sb); dma16s(Kb, kp + (_t0 + 32) * 128, _sb + 4096); \
        dma16s(Vb, vp + _t0 * 2, _sb + 8192); dma16s(Vb, vp + (32 * TB + _t0) * 2, _sb + 8192 + 4096); } while (0)
    WAIT_BAR(0);
    ATT_ISSUE(0, 0);
    ATT_ISSUE(1, 1);
    bf16x8 qf[4];
#pragma unroll
    for (int ks = 0; ks < 4; ++ks) qf[ks] = *(const bf16x8*)(qptr + (size_t)l31 * qstride + 16 * ks + 8 * hh);
    asm volatile("" :: "v"(qf[0]), "v"(qf[1]), "v"(qf[2]), "v"(qf[3]));
    f32x16 O0, O1;
#pragma unroll
    for (int e = 0; e < 16; ++e) { O0[e] = 0.f; O1[e] = 0.f; }
    float mrun = (MODE == 1) ? sink_l2 : -1e30f;
    f32x16 Lacc;
#pragma unroll
    for (int e = 0; e < 16; ++e) Lacc[e] = (MODE == 1) ? 1.f : 0.f;
    const bf16x8 ones = __builtin_bit_cast(bf16x8, (u32x4){0x3F803F80u, 0x3F803F80u, 0x3F803F80u, 0x3F803F80u});
    const int tq = tq_base + l31;
    int cq = 0, cs_ = 0, rs = 0;
    if (MODE == 2) { cq = tq & 63; cs_ = min(max(cq - 8, 0), 48); rs = min(max(rq - 4, 0), 24); }
    const int swz = (l31 >> 1) & 7;
    const char* kbase = lds + l31 * 128;
    const char* vbase = lds + 8192 + l31 * 128;
    int rst = 0, ist = 2;
#pragma unroll 1
    for (int it = 0; it < nt; ++it) {
        if ((it & 1) == 0) {
            WAIT_BAR(0);
            if (it + 2 < nt) { ATT_ISSUE(it + 2, ist); ATT_ISSUE(it + 3, ((ist + 1) & 3)); ist = (ist + 2) & 3; }
        }
        const char* ldsK = kbase + rst * ASTAGE;
        const char* ldsV = vbase + rst * ASTAGE;
        rst = (rst + 1) & 3;
        bool active = true;
        int krow = 0;
        if (MODE == 2 && it >= 4) { krow = (lat_lo >> 6) + it - 4; active = (krow >= rs) && (krow < rs + 8); }
        if (active) {
            f32x16 s0, s1;
#pragma unroll
            for (int e = 0; e < 16; ++e) { s0[e] = 0.f; s1[e] = 0.f; }
            bf16x8 kf[2][4];
#pragma unroll
            for (int ks = 0; ks < 4; ++ks) {
                const int ch = ((2 * ks + hh) ^ swz) * 16;
                kf[0][ks] = *(const bf16x8*)(ldsK + ch);
                kf[1][ks] = *(const bf16x8*)(ldsK + 32 * 128 + ch);
            }
#pragma unroll
            for (int ks = 0; ks < 4; ++ks) {
                s0 = MFMA32(kf[0][ks], qf[ks], s0);
                s1 = MFMA32(kf[1][ks], qf[ks], s1);
            }
            bf16x8 vf[2][4];
#pragma unroll
            for (int q = 0; q < 4; ++q) {
                const int ch = ((2 * q + hh) ^ swz) * 16;
                vf[0][q] = *(const bf16x8*)(ldsV + ch);
                vf[1][q] = *(const bf16x8*)(ldsV + 32 * 128 + ch);
            }
            if (MODE != 2) {
                __builtin_amdgcn_sched_group_barrier(0x100, 8, 0);
                __builtin_amdgcn_sched_group_barrier(0x008, 8, 0);
                __builtin_amdgcn_sched_group_barrier(0x100, 8, 0);
            }
            if (MODE == 1 && it >= 4) {
                const int base = lat_lo + (it - 4) * 64 + 4 * hh - tq + 128;
#pragma unroll
                for (int e = 0; e < 16; ++e) {
                    const int o = (e >> 2) * 8 + (e & 3);
                    s0[e] = ((unsigned)(base + o) <= 256u) ? s0[e] : -1e30f;
                    s1[e] = ((unsigned)(base + 32 + o) <= 256u) ? s1[e] : -1e30f;
                }
            } else if (MODE == 2 && it >= 4) {
                const float* rpl = rpb_lds + (krow - rq + 7) * 31 + (4 * hh - cq + 15);
                const int vt = 4 * hh - cs_;
#pragma unroll
                for (int e = 0; e < 16; ++e) {
                    const int kcst = (e >> 2) * 8 + (e & 3);
                    const float b0 = rpl[kcst], b1 = rpl[kcst + 32];
                    s0[e] = ((unsigned)(kcst + vt) < 16u) ? (s0[e] + b0) : -1e30f;
                    s1[e] = ((unsigned)(kcst + 32 + vt) < 16u) ? (s1[e] + b1) : -1e30f;
                }
            }
            float mx = max3f(s0[0], s1[0], s0[1]);
#pragma unroll
            for (int e = 1; e < 15; ++e) mx = max3f(mx, s1[e], s0[e + 1]);
            mx = max3f(mx, s1[15], s1[15]) * LOG2E;
            if (__any(mx > mrun + 8.0f)) {
                const float mnew = max3f(mrun, mx, __shfl_xor(mx, 32));
                const float alpha = __builtin_amdgcn_exp2f(mrun - mnew);
#pragma unroll
                for (int e = 0; e < 16; ++e) { O0[e] *= alpha; O1[e] *= alpha; Lacc[e] *= alpha; }
                mrun = mnew;
            }
#pragma unroll
            for (int e = 0; e < 16; ++e) {
                s0[e] = __builtin_amdgcn_exp2f(__builtin_fmaf(s0[e], LOG2E, -mrun));
                s1[e] = __builtin_amdgcn_exp2f(__builtin_fmaf(s1[e], LOG2E, -mrun));
            }
            bf16x8 pf[2][2];
#pragma unroll
            for (int s = 0; s < 2; ++s) {
                u32x4 a, b;
                a[0] = pk2(s0[8 * s + 0], s0[8 * s + 1]); a[1] = pk2(s0[8 * s + 2], s0[8 * s + 3]); a[2] = pk2(s0[8 * s + 4], s0[8 * s + 5]); a[3] = pk2(s0[8 * s + 6], s0[8 * s + 7]);
                b[0] = pk2(s1[8 * s + 0], s1[8 * s + 1]); b[1] = pk2(s1[8 * s + 2], s1[8 * s + 3]); b[2] = pk2(s1[8 * s + 4], s1[8 * s + 5]); b[3] = pk2(s1[8 * s + 6], s1[8 * s + 7]);
                pf[0][s] = __builtin_bit_cast(bf16x8, a); pf[1][s] = __builtin_bit_cast(bf16x8, b);
            }
#pragma unroll
            for (int sub = 0; sub < 2; ++sub)
#pragma unroll
                for (int s = 0; s < 2; ++s) {
                    O0 = MFMA32(vf[0][2 * sub + s], pf[sub][s], O0);
                    O1 = MFMA32(vf[1][2 * sub + s], pf[sub][s], O1);
                    Lacc = MFMA32(ones, pf[sub][s], Lacc);
                }
        }
    }
#undef ATT_ISSUE
    const float inv = 1.0f / Lacc[0];
    const bf16_t* gp = gptr + (size_t)l31 * gstride;
    bf16_t* op = optr + (size_t)l31 * 1024;
#pragma unroll
    for (int half = 0; half < 2; ++half)
#pragma unroll
        for (int pr = 0; pr < 2; ++pr) {
            unsigned pk[4];
#pragma unroll
            for (int q = 0; q < 2; ++q) {
                const int g = 2 * pr + q, d = 32 * half + 8 * g + 4 * hh;
                const u32x2 gg = *(const u32x2*)(gp + d);
                const float a0 = (half ? O1[4 * g] : O0[4 * g]), a1 = (half ? O1[4 * g + 1] : O0[4 * g + 1]), a2 = (half ? O1[4 * g + 2] : O0[4 * g + 2]), a3 = (half ? O1[4 * g + 3] : O0[4 * g + 3]);
                pk[2 * q] = pk2(a0 * inv * bf_lo(gg[0]), a1 * inv * bf_hi(gg[0]));
                pk[2 * q + 1] = pk2(a2 * inv * bf_lo(gg[1]), a3 * inv * bf_hi(gg[1]));
            }
            store_pair16(op + 32 * half + 16 * pr, hh, pk[0], pk[1], pk[2], pk[3]);
        }
}

DI void even_mix_phase(const Params& p, int layer, char* lds, const Grp& g) {
    const int j = layer >> 1;
    const bool upd = layer < 3;
    const int w = __builtin_amdgcn_readfirstlane(otid() >> 6);
    const int local = g.local, nlocal = g.nlocal;
    const int per_b = 256 + (upd ? 32 : 0);
    for (int xcd = g.xcd; xcd < NB; xcd += g.nx)
    for (int li = local; li < per_b; li += nlocal) {
        const int item = (li < 128) ? (xcd * 128 + li) : (li < 256) ? (1024 + xcd * 128 + (li - 128)) : (2048 + xcd * 32 + (li - 256));
        if (item < 2048) {
            const bool isB = item >= 1024;
            const int it2 = item & 1023;
            const int b = it2 >> 7, kvh = (it2 >> 6) & 1, qt = it2 & 63;
            const int slot = (isB ? 2 : 0) + kvh;
            const int head = kvh * 4 + w;
            const int col = (isB ? 512 : 0) + head * 64;
            const int r0 = b * TB + CTX + qt * 32;
            const bf16_t* Kb = p.kbuf + (size_t)(b * 4 + slot) * TB * 64;
            const bf16_t* Vb = p.vT + (size_t)(b * 4 + slot) * 64 * TB;
            const bf16_t* qp = p.qbuf + (size_t)r0 * 1024 + col;
            const bf16_t* gp = p.gbuf + (size_t)r0 * 1024 + col;
            bf16_t* op = p.h + (size_t)r0 * 1024 + col;
            if (!isB) attn_block<0>(lds, Kb, Vb, 36, 0, qp, 1024, gp, 1024, op, 0.f, qt * 32, nullptr, 0);
            else {
                const int q0 = qt * 32;
                int lo = max(0, q0 - 128) & ~63;
                int hi = (min(SEQ, q0 + 160) + 63) & ~63;
                if (((hi - lo) >> 6) & 1) { if (hi < SEQ) hi += 64; else lo -= 64; }
                attn_block<1>(lds, Kb, Vb, 4 + ((hi - lo) >> 6), lo, qp, 1024, gp, 1024, op, p.b_sink[j * 8 + head] * LOG2E, q0, nullptr, 0);
            }
        } else {
            const int idx = item - 2048;
            const int b = idx >> 5, slot = (idx >> 3) & 3, qt = idx & 7;
            const bool isB = slot >= 2;
            const int head = (slot & 1) * 4 + w;
            const int col = (isB ? 512 : 0) + head * 64;
            const int r0 = b * TB + qt * 32;
            const bf16_t* Kb = p.kbuf + (size_t)(b * 4 + slot) * TB * 64;
            const bf16_t* Vb = p.vT + (size_t)(b * 4 + slot) * 64 * TB;
            const bf16_t* qp = p.qbuf + (size_t)r0 * 1024 + col;
            const bf16_t* gp = p.gbuf + (size_t)r0 * 1024 + col;
            bf16_t* op = p.h + (size_t)r0 * 1024 + col;
            if (!isB) attn_block<0>(lds, Kb, Vb, 4, 0, qp, 1024, gp, 1024, op, 0.f, 0, nullptr, 0);
            else attn_block<1>(lds, Kb, Vb, 4, 0, qp, 1024, gp, 1024, op, p.b_sink[j * 8 + head] * LOG2E, 0, nullptr, 0);
        }
    }
}

constexpr int CT = 16;
DI void conv_item(const Params& p, int j, int rbase  , int seglen, int t0, char* lds) {
    const int tid = otid(), lane = tid & 63, w = tid >> 6;
    const int c = 2 * tid;
    float wt[31][2];
    const float* wb = p.c_dw_w + (size_t)j * 31 * 512 + c;
    const bf16_t* cb = p.cbuf + (size_t)rbase * 1536 + c;
    asm volatile("" : "+v"(wb));
    asm volatile("" : "+v"(cb));
#pragma unroll
    for (int k = 0; k < 31; ++k) { const f32x2 v = *(const f32x2*)(wb + k * 512); wt[k][0] = v[0]; wt[k][1] = v[1]; }
    const f32x2 bias = *(const f32x2*)(p.c_dw_b + j * 512 + c);
    float acc[CT][2];
#pragma unroll
    for (int o = 0; o < CT; ++o) { acc[o][0] = bias[0]; acc[o][1] = bias[1]; }
#pragma unroll
    for (int i = 0; i < CT + 30; ++i) {
        const int pos = t0 - 15 + i;
        float u0 = 0.f, u1 = 0.f;
        if (pos >= 0 && pos < seglen) {
            const bf16_t* rp = cb + (ptrdiff_t)pos * 1536;
            const unsigned a = *(const unsigned*)rp, g = *(const unsigned*)(rp + 512);
            u0 = bf_lo(a) * sigmoid_f(bf_lo(g)); u1 = bf_hi(a) * sigmoid_f(bf_hi(g));
        }
#pragma unroll
        for (int o = 0; o < CT; ++o) {
            const int k = i - o;
            if (k >= 0 && k < 31) { acc[o][0] += wt[k][0] * u0; acc[o][1] += wt[k][1] * u1; }
        }
    }
    float* red = (float*)lds;
    float* stat = red + CT * 8;
    __syncthreads();
#pragma unroll
    for (int o = 0; o < CT; ++o) {
        float s1 = acc[o][0] + acc[o][1], s2 = acc[o][0] * acc[o][0] + acc[o][1] * acc[o][1];
#pragma unroll
        for (int sh = 32; sh >= 1; sh >>= 1) { s1 += __shfl_xor(s1, sh); s2 += __shfl_xor(s2, sh); }
        if (lane == 0) { red[(o * 4 + w) * 2] = s1; red[(o * 4 + w) * 2 + 1] = s2; }
    }
    __syncthreads();
    if (tid < CT) {
        float s1 = 0.f, s2 = 0.f;
#pragma unroll
        for (int q = 0; q < 4; ++q) { s1 += red[(tid * 4 + q) * 2]; s2 += red[(tid * 4 + q) * 2 + 1]; }
        const float mean = s1 * (1.0f / 512.0f);
        const float var = fmaxf(s2 * (1.0f / 512.0f) - mean * mean, 0.f);
        stat[tid * 2] = mean; stat[tid * 2 + 1] = rsqrtf(var + EPS);
    }
    __syncthreads();
    const f32x2 lg = *(const f32x2*)(p.c_ln_g + j * 512 + c), lb = *(const f32x2*)(p.c_ln_b + j * 512 + c);
#pragma unroll
    for (int o = 0; o < CT; ++o) {
        const f32x2 st = *(const f32x2*)(stat + 2 * o);
        const float mean = st[0], rstd = st[1];
        const size_t r = (size_t)(rbase + t0 + o);
        const unsigned sg = *(const unsigned*)(cb + (ptrdiff_t)(t0 + o) * 1536 + 1024);
        const float y0 = silu_f((acc[o][0] - mean) * rstd * lg[0] + lb[0]) * bf_lo(sg);
        const float y1 = silu_f((acc[o][1] - mean) * rstd * lg[1] + lb[1]) * bf_hi(sg);
        *(unsigned*)(p.h + r * 1024 + c) = pk2(y0, y1);
    }
}

DI void odd_mix_phase(const Params& p, int layer, char* lds, const Grp& g) {
    const int j = layer >> 1;
    const bool upd = layer < 3;
    const int tid = otid(), w = __builtin_amdgcn_readfirstlane(tid >> 6);
    constexpr int NCL = NB * SEQ / CT, NCC = NB * CTX / CT, I1 = 1024 + NCL, I2 = I1 + 128;
    const int total = I1 + (upd ? 128 + NCC : 0); (void)total;
    const int local = g.local, nlocal = g.nlocal;
    constexpr int PCL = NCL / NB, PCC = NCC / NB;
    const int per_b = 128 + PCL + (upd ? 16 + PCC : 0);
    float* rpb_lds = (float*)(lds + 4 * 16384) + 64;
    for (int xcd = g.xcd; xcd < NB; xcd += g.nx)
    for (int li = local; li < per_b; li += nlocal) {
        const int item = (li < 128) ? (xcd * 128 + li) : (li < 128 + PCL) ? (1024 + xcd * PCL + (li - 128)) : (li < 128 + PCL + 16) ? (I1 + xcd * 16 + (li - 128 - PCL)) : (I2 + xcd * PCC + (li - 128 - PCL - 16));
        if (item < 1024) {
            const int b = item >> 7, hd = (item >> 4) & 7, rp = item & 15;
            __syncthreads();
            for (int i = tid; i < 465 + 128; i += 256) { const int k = i - 64; rpb_lds[k] = (k >= 0 && k < 465) ? p.d_rpb[((size_t)j * 8 + hd) * 465 + k] : 0.f; }
            const int rq = 2 * rp + (w >> 1);
            int lo_row = min(max(2 * rp - 4, 0), 24), hi_row = min(max(2 * rp + 1 - 4, 0), 24) + 8;
            if ((hi_row - lo_row) & 1) { if (hi_row < 32) ++hi_row; else --lo_row; }
            const int tq0 = rq * 64 + (w & 1) * 32;
            const int r0 = b * TB + CTX + tq0;
            const bf16_t* Kb = p.kbuf + (size_t)(b * 8 + hd) * TB * 64;
            const bf16_t* Vb = p.vT + (size_t)(b * 8 + hd) * 64 * TB;
            attn_block<2>(lds, Kb, Vb, 4 + (hi_row - lo_row), lo_row * 64, p.qbuf + (size_t)r0 * 512 + hd * 64, 512, p.gbuf + (size_t)r0 * 512 + hd * 64, 512,
                          p.h + (size_t)r0 * 1024 + 512 + hd * 64, 0.f, tq0, rpb_lds, rq);
        } else if (item >= I1 && item < I2) {
            const int idx = item - I1, b = idx >> 4, hd = (idx >> 1) & 7, half = idx & 1;
            const int r0 = b * TB + half * 128 + w * 32;
            const bf16_t* Kb = p.kbuf + (size_t)(b * 8 + hd) * TB * 64;
            const bf16_t* Vb = p.vT + (size_t)(b * 8 + hd) * 64 * TB;
            attn_block<0>(lds, Kb, Vb, 4, 0, p.qbuf + (size_t)r0 * 512 + hd * 64, 512, p.gbuf + (size_t)r0 * 512 + hd * 64, 512,
                          p.h + (size_t)r0 * 1024 + 512 + hd * 64, 0.f, 0, nullptr, 0);
        } else {
            int rbase, seglen, t0;
            if (item < I1) { const int idx = item - 1024; rbase = (idx / (SEQ / CT)) * TB + CTX; seglen = SEQ; t0 = (idx % (SEQ / CT)) * CT; }
            else { const int idx = item - I2; rbase = (idx / (CTX / CT)) * TB; seglen = CTX; t0 = (idx % (CTX / CT)) * CT; }
            conv_item(p, j, rbase, seglen, t0, lds);
        }
    }
}

#ifndef PMASK
#define PMASK 0xff
#endif
DI void run_phase(const Params& p, int ph, char* lds, const Grp& g) {
    if (ph == 0) { phase0(p, lds); return; }
    if (ph == 17) { final_phase(p, g); return; }
    const int layer = (ph - 1) >> 2, sub = (ph - 1) & 3;
    if (sub == 0) norm_phase(p, layer, g);
    else if (sub == 1) gemm_in_phase(p, layer, lds, g);
    else if (sub == 2) { if (layer & 1) odd_mix_phase(p, layer, lds, g); else even_mix_phase(p, layer, lds, g); }
    else gemm_out_phase(p, layer, lds, g);
}

__global__ void __launch_bounds__(256, 2) fwd_kernel(Params p, int ph0, int ph1) {
    __shared__ __attribute__((aligned(16))) char lds[LDS_BYTES];
    __shared__ uint4 xb_words;
    XcdBarrier xb;
    const bool multi = (ph1 - ph0) > 1;
    Grp g; g.xcd = blockIdx.x & 7; g.local = blockIdx.x >> 3; g.nlocal = gridDim.x >> 3; g.nx = 8;
    if (multi) {
        if (threadIdx.x == 0) xb_words = make_uint4(0u, 0u, 0u, 0u);
        __syncthreads();
        xb = xcd_barrier_post(p.bar, (volatile LAS unsigned*)&xb_words);
    }
#ifdef CLOCK_PROBE
    const unsigned long long ct0 = __builtin_amdgcn_s_memtime(), cr0 = __builtin_amdgcn_s_memrealtime();
#endif
    for (int ph = ph0; ph < ph1; ++ph) {
        if (ph > ph0) {
            if (ph == ph0 + 1) {
                xcd_barrier(xb);
                g.nlocal = (int)xb.st[0]; g.nx = (int)xb.st[1]; g.xcd = (int)xb.st[2]; g.local = (int)xb.st[3];
            } else xcc_barrier(xb);
        }
        run_phase(p, ph, lds, g);
    }
#ifdef CLOCK_PROBE
    if (blockIdx.x == 0 && threadIdx.x == 0) {
        const unsigned long long ct1 = __builtin_amdgcn_s_memtime(), cr1 = __builtin_amdgcn_s_memrealtime();
        const unsigned long long mhz = (ct1 - ct0) * 100ull / (cr1 - cr0 + 1ull);
        const unsigned long long extra = mhz * 10ull;
        while (__builtin_amdgcn_s_memrealtime() - cr1 < extra) __builtin_amdgcn_s_sleep(8);
    }
#endif
}

extern "C" void kernel_launch(void* const* d_in, const int* in_sizes, int n_in, void* d_out, int out_size, void* d_ws, size_t ws_size, hipStream_t stream) {
    Params p{};
    p.x = (const float*)d_in[0]; p.c = (const float*)d_in[1]; p.ctx = (const float*)d_in[2]; p.c_ctx = (const float*)d_in[3];
    p.mod_w = (const float*)d_in[4]; p.mod_b = (const float*)d_in[5]; p.norm_g = (const float*)d_in[6];
    p.ev_w_in = (const float*)d_in[7]; p.ev_w_out = (const float*)d_in[8]; p.a_q_gain = (const float*)d_in[9]; p.a_k_gain = (const float*)d_in[10]; p.b_sink = (const float*)d_in[11];
    p.od_w_in = (const float*)d_in[12]; p.od_w_out = (const float*)d_in[13]; p.c_dw_w = (const float*)d_in[14]; p.c_dw_b = (const float*)d_in[15];
    p.c_ln_g = (const float*)d_in[16]; p.c_ln_b = (const float*)d_in[17]; p.d_rpb = (const float*)d_in[18]; p.final_g = (const float*)d_in[19];
    p.out = (float*)d_out;
    char* ws = (char*)d_ws; size_t off = 0;
    auto take = [&](size_t bytes) { char* r = ws + off; off += (bytes + 255) & ~(size_t)255; return r; };
    p.bar = (unsigned*)take(XCD_BAR_WORDS * 4);
    p.mvec = (float*)take((size_t)4 * 9 * 3072 * 4);
    p.rope = (float*)take((size_t)2048 * 64 * 4);
    p.wt_ev_in = (bf16_t*)take((size_t)2 * 2560 * 1024 * 2);
    p.wt_ev_out = (bf16_t*)take((size_t)2 * 1024 * 1024 * 2);
    p.wt_od_in = (bf16_t*)take((size_t)2 * 3584 * 1024 * 2);
    p.wt_od_out = (bf16_t*)take((size_t)2 * 1024 * 1024 * 2);
    p.xctx = (float*)take((size_t)NB * CTX * DM * 4);
    p.h = (bf16_t*)take((size_t)MROWS * 1024 * 2);
    p.qbuf = (bf16_t*)take((size_t)MROWS * 1024 * 2);
    p.gbuf = (bf16_t*)take((size_t)MROWS * 1024 * 2);
    p.cbuf = (bf16_t*)take((size_t)MROWS * 1536 * 2);
    p.kbuf = (bf16_t*)take((size_t)NB * 8 * TB * 64 * 2);
    p.vT = (bf16_t*)take((size_t)NB * 8 * 64 * TB * 2);
    if (off > ws_size) { fprintf(stderr, "workspace too small: need %zu have %zu\n", off, ws_size); return; }

    static int grid_blocks = 0;
    if (!grid_blocks) {
        int dev = 0, cus = 0, per_cu = 0;
        hipGetDevice(&dev);
        hipDeviceGetAttribute(&cus, hipDeviceAttributeMultiprocessorCount, dev);
        hipOccupancyMaxActiveBlocksPerMultiprocessor(&per_cu, fwd_kernel, 256, 0);
        if (per_cu > 2) per_cu = 2;
        if (per_cu < 1) per_cu = 1;
        grid_blocks = cus * per_cu;
        grid_blocks &= ~7;
    }
#if MULTI_LAUNCH
    for (int ph = 0; ph < 18; ++ph) hipLaunchKernelGGL(fwd_kernel, dim3(grid_blocks), dim3(256), 0, stream, p, ph, ph + 1);
#else
    hipMemsetAsync(p.bar, 0, XCD_BAR_WORDS * 4, stream);
    int ph0 = 0, ph1 = 18;
    void* args[] = {&p, &ph0, &ph1};
    hipError_t e = hipLaunchCooperativeKernel((void*)fwd_kernel, dim3(grid_blocks), dim3(256), args, 0, stream);
    if (e != hipSuccess) fprintf(stderr, "cooperative launch failed: %s (grid %d)\n", hipGetErrorString(e), grid_blocks);
#endif
}
```

```cpp
#include <hip/hip_runtime.h>
#include <hip/hip_cooperative_groups.h>
#include <cstdint>
#include <cstdio>

#ifndef MULTI_LAUNCH
#define MULTI_LAUNCH 0
#endif

#define DI __device__ __forceinline__
#define LAS __attribute__((address_space(3)))

typedef unsigned short bf16_t;
typedef short bf16x8 __attribute__((ext_vector_type(8)));
typedef float f32x16 __attribute__((ext_vector_type(16)));
typedef float f32x4 __attribute__((ext_vector_type(4)));
typedef float f32x2 __attribute__((ext_vector_type(2)));
typedef unsigned u32x4 __attribute__((ext_vector_type(4)));
typedef unsigned u32x2 __attribute__((ext_vector_type(2)));
typedef __bf16 bf16v2 __attribute__((ext_vector_type(2)));

constexpr int NB = 8, SEQ = 2048, DM = 1024, CTX = 256, TB = 2304, MROWS = NB * TB;
constexpr float EPS = 1e-6f, LOG2E = 1.4426950408889634f;
constexpr int LROW = 144;
constexpr int GT_BYTES = 128 * LROW;
constexpr int LDS_BYTES = 73728;

struct Params {
    const float *x, *c, *ctx, *c_ctx, *mod_w, *mod_b, *norm_g, *ev_w_in, *ev_w_out, *a_q_gain, *a_k_gain, *b_sink,
        *od_w_in, *od_w_out, *c_dw_w, *c_dw_b, *c_ln_g, *c_ln_b, *d_rpb, *final_g;
    float* out;
    unsigned* bar;
    float* mvec;
    float* rope;
    bf16_t *wt_ev_in, *wt_ev_out, *wt_od_in, *wt_od_out;
    float* xctx;
    bf16_t* h;
    bf16_t* qbuf;
    bf16_t* gbuf;
    bf16_t* cbuf;
    bf16_t* kbuf;
    bf16_t* vT;
};

DI unsigned pk2(float a, float b) { f32x2 v = {a, b}; bf16v2 r = __builtin_convertvector(v, bf16v2); return __builtin_bit_cast(unsigned, r); }
DI float bf_lo(unsigned u) { return __uint_as_float(u << 16); }
DI float bf_hi(unsigned u) { return __uint_as_float(u & 0xffff0000u); }
DI float silu_f(float x) { return x * __builtin_amdgcn_rcpf(1.f + __builtin_amdgcn_exp2f(-LOG2E * x)); }
DI float sigmoid_f(float x) { return __builtin_amdgcn_rcpf(1.f + __builtin_amdgcn_exp2f(-LOG2E * x)); }
DI int otid() { int t = threadIdx.x; asm volatile("" : "+v"(t)); return t; }
DI float max3f(float a, float b, float c) { float r; asm("v_max3_f32 %0, %1, %2, %3" : "=v"(r) : "v"(a), "v"(b), "v"(c)); return r; }
#define MFMA32(a, b, c) __builtin_amdgcn_mfma_f32_32x32x16_bf16((a), (b), (c), 0, 0, 0)

DI const float* res_in_row(const Params& p, int layer, int r) {
    const int b = r / TB, t = r - b * TB;
    if (t < CTX) return (layer == 0 ? p.ctx : (const float*)p.xctx) + (size_t)(b * CTX + t) * DM;
    return (layer == 0 ? p.x : (const float*)p.out) + (size_t)(b * SEQ + t - CTX) * DM;
}
DI float* res_out_row(const Params& p, int r) {
    const int b = r / TB, t = r - b * TB;
    if (t < CTX) return p.xctx + (size_t)(b * CTX + t) * DM;
    return p.out + (size_t)(b * SEQ + t - CTX) * DM;
}

#define XB_TMO      128
#define XB_XCNT(j)  (256  + 64 * (j))
#define XB_XSUB(j)  (1280 + 64 * (j))
#define XB_XGEN(j)  (2304 + 64 * (j))
#define XB_TOP      3328
#define XB_TOPGEN   3392
#define XB_LSUB(j)  (3456 + 64 * (j))
#define XB_LGEN(j)  (4480 + 64 * (j))
#define XCD_BAR_WORDS 5504
#define XB_SPIN_CAP (1u << 22)
DI unsigned xb_ld(unsigned* p) { return __hip_atomic_load(p, __ATOMIC_RELAXED, __HIP_MEMORY_SCOPE_AGENT); }
DI unsigned xb_add(unsigned* p, unsigned v) { return __hip_atomic_fetch_add(p, v, __ATOMIC_RELAXED, __HIP_MEMORY_SCOPE_AGENT); }
DI unsigned xb_xcc_id() { return (unsigned)__builtin_amdgcn_s_getreg((3 << 11) | 20) & 0xFu; }
#define XB_SPIN(cond, bar) do { unsigned _sp = 0; while (cond) { __builtin_amdgcn_s_sleep(1); \
    if ((++_sp & 255u) == 0u) { if (xb_ld(&(bar)[XB_TMO])) break; if (_sp > XB_SPIN_CAP) { atomicAdd(&(bar)[XB_TMO], 1u); break; } } } } while (0)
struct XcdBarrier { unsigned* bar; unsigned x; volatile LAS unsigned* st; };
DI XcdBarrier xcd_barrier_post(unsigned* bar, volatile LAS unsigned* st) {
    XcdBarrier b; b.bar = bar; b.x = xb_xcc_id(); b.st = st;
    if (threadIdx.x == 0) st[3] = xb_add(&bar[XB_XCNT(b.x)], 1u);
    return b;
}
DI void xcd_barrier_complete(unsigned* bar, unsigned x, unsigned& nloc, unsigned& nx, unsigned& xidx) {
    const unsigned G = gridDim.x * gridDim.y * gridDim.z;
    unsigned sum, cnt, mine, below, sp = 0u;
    for (;;) {
        sum = 0u; cnt = 0u; mine = 0u; below = 0u;
#pragma unroll
        for (unsigned j = 0; j < 16; ++j) { const unsigned c = xb_ld(&bar[XB_XCNT(j)]); sum += c; cnt += (c > 0u) ? 1u : 0u; mine = (j == x) ? c : mine; below += (c > 0u && j < x) ? 1u : 0u; }
        if (sum == G) break;
        __builtin_amdgcn_s_sleep(1);
        if ((++sp & 255u) == 0u) { if (xb_ld(&bar[XB_TMO])) break; if (sp > XB_SPIN_CAP) { atomicAdd(&bar[XB_TMO], 1u); break; } }
    }
    nloc = mine > 0u ? mine : 1u; nx = cnt > 0u ? cnt : 1u; xidx = below;
}
DI void xcd_barrier(const XcdBarrier& b) {
    asm volatile("s_waitcnt vmcnt(0)" ::: "memory");
    __syncthreads();
    if (threadIdx.x == 0) {
        unsigned* bar = b.bar;
        asm volatile("" : "+s"(bar));
        __builtin_amdgcn_s_waitcnt(0);
        unsigned nloc = b.st[0], nx = b.st[1];
        if (nloc == 0u) { unsigned xidx; xcd_barrier_complete(bar, b.x, nloc, nx, xidx); b.st[0] = nloc; b.st[1] = nx; b.st[2] = xidx; }
        const unsigned old = xb_add(&bar[XB_XSUB(b.x)], 1u);
        const unsigned gen = old / nloc;
        if (old + 1u == (gen + 1u) * nloc) {
            __builtin_amdgcn_fence(__ATOMIC_RELEASE, "agent");
            asm volatile("s_waitcnt vmcnt(0)" ::: "memory");
            const unsigned og = xb_add(&bar[XB_TOP], 1u);
            const unsigned tg = og / nx;
            if (og + 1u == (tg + 1u) * nx) xb_add(&bar[XB_TOPGEN], 1u);
            else XB_SPIN(xb_ld(&bar[XB_TOPGEN]) == tg, bar);
            __builtin_amdgcn_fence(__ATOMIC_ACQUIRE, "agent");
            xb_add(&bar[XB_XGEN(b.x)], 1u);
            asm volatile("s_waitcnt vmcnt(0)" ::: "memory");
        } else {
            XB_SPIN(xb_ld(&bar[XB_XGEN(b.x)]) == gen, bar);
            __builtin_amdgcn_fence(__ATOMIC_ACQUIRE, "agent");
            asm volatile("s_waitcnt vmcnt(0)" ::: "memory");
        }
    }
    __syncthreads();
}

DI void xcc_barrier(const XcdBarrier& b) {
    asm volatile("s_waitcnt vmcnt(0)" ::: "memory");
    __syncthreads();
    if (threadIdx.x == 0) {
        unsigned* bar = b.bar;
        asm volatile("" : "+s"(bar));
        __builtin_amdgcn_s_waitcnt(0);
        const unsigned nloc = b.st[0];
        const unsigned old = xb_add(&bar[XB_LSUB(b.x)], 1u);
        const unsigned gen = old / nloc;
        if (old + 1u == (gen + 1u) * nloc) xb_add(&bar[XB_LGEN(b.x)], 1u);
        else XB_SPIN(xb_ld(&bar[XB_LGEN(b.x)]) == gen, bar);
        __builtin_amdgcn_fence(__ATOMIC_ACQUIRE, "agent");
        asm volatile("s_waitcnt vmcnt(0)" ::: "memory");
    }
    __syncthreads();
}

struct Grp { int xcd, local, nlocal, nx; };

DI void mod_item(const Params& p, char* lds, int item) {
    const int tid = otid();
    const int layer = item / 48, n0 = (item % 48) * 64;
    float* sc = (float*)lds;
    float* part = (float*)(lds + 36864);
    __syncthreads();
    for (int i = tid; i < 9 * 1024; i += 256) { const int j = i >> 10, k = i & 1023; const float v = (j < 8) ? p.c[j * 1024 + k] : p.c_ctx[k]; sc[i] = silu_f(v); }
    __syncthreads();
    const int kg = tid >> 4, c4 = (tid & 15) * 4;
    f32x4 acc[9];
#pragma unroll
    for (int j = 0; j < 9; ++j) acc[j] = (f32x4){0.f, 0.f, 0.f, 0.f};
    const float* wp = p.mod_w + ((size_t)layer * 1024 + kg * 64) * 3072 + n0 + c4;
    const float* scp = sc + kg * 64;
#pragma unroll 16
    for (int k = 0; k < 64; ++k) {
        const f32x4 wv = *(const f32x4*)(wp + (size_t)k * 3072);
#pragma unroll
        for (int j = 0; j < 9; ++j) { const float sv = scp[j * 1024 + k]; acc[j] += wv * sv; }
    }
#pragma unroll
    for (int j = 0; j < 9; ++j) *(f32x4*)(part + (kg * 9 + j) * 64 + c4) = acc[j];
    __syncthreads();
    for (int i = tid; i < 9 * 64; i += 256) {
        const int j = i >> 6, cc = i & 63;
        float sm = p.mod_b[layer * 3072 + n0 + cc];
#pragma unroll
        for (int g = 0; g < 16; ++g) sm += part[(g * 9 + j) * 64 + cc];
        p.mvec[((size_t)layer * 9 + j) * 3072 + n0 + cc] = sm;
    }
}

DI void rope_item(const Params& p, int item) {
    const int idx = item * 256 + otid();
    const int t = idx >> 5, pp = idx & 31;
    const float pos = (float)((pp < 16) ? (t >> 6) : (t & 63));
    const float freq = powf(10000.0f, -(float)(pp & 15) / 16.0f);
    const float ang = pos * freq;
    float sn, cs; sincosf(ang, &sn, &cs);
    *(f32x2*)(p.rope + (size_t)idx * 2) = (f32x2){cs, sn};
}

DI void wconv_item(const float* __restrict__ W, bf16_t* __restrict__ Wt, int N, int tile, char* lds) {
    const int tid = otid();
    const int ntn = N >> 6, kt = tile / ntn, nt_ = tile - kt * ntn, k0 = kt * 64, n0 = nt_ * 64;
    float* tl = (float*)lds;
    __syncthreads();
#pragma unroll
    for (int j = 0; j < 4; ++j) {
        const int kk = (tid >> 4) + 16 * j, nn = (tid & 15) * 4;
        const f32x4 v = *(const f32x4*)(W + (size_t)(k0 + kk) * N + n0 + nn);
        tl[kk * 65 + nn + 0] = v[0]; tl[kk * 65 + nn + 1] = v[1]; tl[kk * 65 + nn + 2] = v[2]; tl[kk * 65 + nn + 3] = v[3];
    }
    __syncthreads();
#pragma unroll
    for (int j = 0; j < 2; ++j) {
        const int idx = tid + 256 * j, n = idx >> 3, kc = (idx & 7) * 8;
        u32x4 o;
        o[0] = pk2(tl[(kc + 0) * 65 + n], tl[(kc + 1) * 65 + n]);
        o[1] = pk2(tl[(kc + 2) * 65 + n], tl[(kc + 3) * 65 + n]);
        o[2] = pk2(tl[(kc + 4) * 65 + n], tl[(kc + 5) * 65 + n]);
        o[3] = pk2(tl[(kc + 6) * 65 + n], tl[(kc + 7) * 65 + n]);
        *(u32x4*)(Wt + (size_t)(n0 + n) * 1024 + k0 + kc) = o;
    }
}

DI void phase0(const Params& p, char* lds) {
    const int total = 192 + 256 + 4096;
    for (int item = blockIdx.x; item < total; item += gridDim.x) {
        if (item < 192) mod_item(p, lds, item);
        else if (item < 448) rope_item(p, item - 192);
        else {
            int w = item - 448; const int j = w >> 11; w &= 2047;
            if (w < 640) wconv_item(p.ev_w_in + (size_t)j * 1024 * 2560, p.wt_ev_in + (size_t)j * 2560 * 1024, 2560, w, lds);
            else if (w < 896) wconv_item(p.ev_w_out + (size_t)j * 1024 * 1024, p.wt_ev_out + (size_t)j * 1024 * 1024, 1024, w - 640, lds);
            else if (w < 1792) wconv_item(p.od_w_in + (size_t)j * 1024 * 3584, p.wt_od_in + (size_t)j * 3584 * 1024, 3584, w - 896, lds);
            else wconv_item(p.od_w_out + (size_t)j * 1024 * 1024, p.wt_od_out + (size_t)j * 1024 * 1024, 1024, w - 1792, lds);
        }
    }
}

DI void norm_phase(const Params& p, int layer, const Grp& grp) {
    const int lane = otid() & 63, w = otid() >> 6;
    const float* g = p.norm_g + layer * 1024;
    const int local = grp.local, nlocal = grp.nlocal;
    for (int xcd = grp.xcd; xcd < NB; xcd += grp.nx)
#pragma unroll 1
        for (int seg = 0; seg < 2; ++seg) {
            const int cond = seg ? xcd : 8;
            const float* mv = p.mvec + ((size_t)layer * 9 + cond) * 3072;
            f32x4 mul[4], add[4];
#pragma unroll
            for (int j = 0; j < 4; ++j) {
                const int c0 = lane * 4 + 256 * j;
                const f32x4 gg = *(const f32x4*)(g + c0), sh = *(const f32x4*)(mv + c0), sc = *(const f32x4*)(mv + 1024 + c0);
#pragma unroll
                for (int e = 0; e < 4; ++e) { mul[j][e] = gg[e] * (1.f + sc[e]); add[j][e] = sh[e]; }
            }
            const int i0 = seg ? CTX / 4 : 0, i1 = seg ? TB / 4 : CTX / 4;
            for (int li = i0 + local; li < i1; li += nlocal) {
                const int r = (xcd * (TB / 4) + li) * 4 + w;
                const float* xr = res_in_row(p, layer, r);
                f32x4 v[4]; float ss = 0.f;
#pragma unroll
                for (int j = 0; j < 4; ++j) { v[j] = *(const f32x4*)(xr + lane * 4 + 256 * j); ss += v[j][0] * v[j][0] + v[j][1] * v[j][1] + v[j][2] * v[j][2] + v[j][3] * v[j][3]; }
#pragma unroll
                for (int o = 32; o >= 1; o >>= 1) ss += __shfl_xor(ss, o);
                const float rstd = rsqrtf(ss * (1.0f / 1024.0f) + EPS);
                bf16_t* hr = p.h + (size_t)r * 1024;
#pragma unroll
                for (int j = 0; j < 4; ++j) {
                    const int c0 = lane * 4 + 256 * j;
                    float y[4];
#pragma unroll
                    for (int e = 0; e < 4; ++e) y[e] = (v[j][e] * rstd) * mul[j][e] + add[j][e];
                    *(u32x2*)(hr + c0) = (u32x2){pk2(y[0], y[1]), pk2(y[2], y[3])};
                }
            }
        }
}

DI void final_phase(const Params& p, const Grp& g) {
    const int lane = otid() & 63, w = otid() >> 6;
    const int local = g.local, nlocal = g.nlocal;
    f32x4 fg[4];
#pragma unroll
    for (int j = 0; j < 4; ++j) fg[j] = *(const f32x4*)(p.final_g + lane * 4 + 256 * j);
    for (int xcd = g.xcd; xcd < NB; xcd += g.nx)
    for (int li = local; li < SEQ / 4; li += nlocal) {
        const int item = xcd * (SEQ / 4) + li;
        const int r = item * 4 + w;
        float* xr = p.out + (size_t)r * 1024;
        f32x4 v[4]; float ss = 0.f;
#pragma unroll
        for (int j = 0; j < 4; ++j) { v[j] = *(const f32x4*)(xr + lane * 4 + 256 * j); ss += v[j][0] * v[j][0] + v[j][1] * v[j][1] + v[j][2] * v[j][2] + v[j][3] * v[j][3]; }
#pragma unroll
        for (int o = 32; o >= 1; o >>= 1) ss += __shfl_xor(ss, o);
        const float rstd = rsqrtf(ss * (1.0f / 1024.0f) + EPS);
#pragma unroll
        for (int j = 0; j < 4; ++j) {
            const int c0 = lane * 4 + 256 * j;
            f32x4 o;
#pragma unroll
            for (int e = 0; e < 4; ++e) o[e] = v[j][e] * rstd * fg[j][e];
            *(f32x4*)(xr + c0) = o;
        }
    }
}

DI void dma16(const void* gsrc, unsigned lds_dst) { unsigned keep;
    asm volatile("s_mov_b32 %0, m0\n\ts_mov_b32 m0, %2\n\ts_nop 0\n\tglobal_load_lds_dwordx4 %1, off\n\ts_mov_b32 m0, %0" : "=&s"(keep) : "v"(gsrc), "s"(lds_dst) : "memory"); }
DI void dma16s(const void* base, unsigned voff, unsigned lds_dst) { unsigned keep;
    asm volatile("s_mov_b32 %0, m0\n\ts_mov_b32 m0, %3\n\ts_nop 0\n\tglobal_load_lds_dwordx4 %1, %2\n\ts_mov_b32 m0, %0" : "=&s"(keep) : "v"(voff), "s"(base), "s"(lds_dst) : "memory"); }
#define WAIT_BAR(N) asm volatile("s_waitcnt vmcnt(" #N ") lgkmcnt(0)\n\ts_barrier" ::: "memory")
#define WAIT_VM(n) asm volatile("s_waitcnt vmcnt(" #n ")" ::: "memory")

template <bool SWAP, int TI, int GP = 0>
DI void gemm_mainloop(const bf16_t* __restrict__ A, const bf16_t* __restrict__ W, int row0, int col0, f32x16 (&acc)[2 * TI], char* lds, bool pre_issued) {
    constexpr int MT = 64 * TI, STAGE = (MT + 128) * 64, NST = (TI == 4) ? 3 : 4, NA = TI, KT = 32;
    const int tid = otid(), lane = tid & 63, w = __builtin_amdgcn_readfirstlane(tid >> 6), wm = w >> 1, wn = w & 1, l31 = lane & 31, hh = lane >> 5;
    const int cc = (lane & 3) ^ ((lane >> 4) & 3);
    const unsigned pa = (unsigned)(((row0 + 16 * w + (lane >> 2)) * 1024 + cc * 8) * 2);
    const unsigned pb = (unsigned)(((col0 + 16 * w + (lane >> 2)) * 1024 + cc * 8) * 2);
    const unsigned l3 = (unsigned)(size_t)lds + w * 1024;
    const int sw = (l31 >> 2) & 3;
    const char* fa = lds + (wm * (32 * TI) + l31) * 64;
    const char* fb = lds + MT * 64 + (wn * 64 + l31) * 64;
    const int ch0 = ((0 + hh) ^ sw) * 16, ch1 = ((2 + hh) ^ sw) * 16;
#pragma unroll
    for (int i = 0; i < 2 * TI; ++i)
#pragma unroll
        for (int e = 0; e < 16; ++e) acc[i][e] = 0.f;
    if (!pre_issued) WAIT_BAR(0);
#define GEMM_ISSUE(kt, st) do { const unsigned _sb = l3 + (st) * STAGE; const int _ko = (kt) * 32; \
        _Pragma("unroll") for (int _j = 0; _j < NA; ++_j) dma16s(A, pa + (_j * 64 * 1024 + _ko) * 2, _sb + _j * 4096); \
        _Pragma("unroll") for (int _j = 0; _j < 2; ++_j) dma16s(W, pb + (_j * 64 * 1024 + _ko) * 2, _sb + MT * 64 + _j * 4096); } while (0)
#define GEMM_STAGE(DO_ISSUE, ktn) do { \
        const char* sa = fa + rs * STAGE; const char* sb = fb + rs * STAGE; \
        const unsigned _sbase = l3 + is * STAGE; const int _ko = (ktn) * 32; \
        bf16x8 af[2][TI], bf[2][2]; \
        _Pragma("unroll") for (int ks = 0; ks < 2; ++ks) { const int ch = ks ? ch1 : ch0; \
            _Pragma("unroll") for (int i = 0; i < TI; ++i) af[ks][i] = *(const bf16x8*)(sa + i * 32 * 64 + ch); \
            _Pragma("unroll") for (int j = 0; j < 2; ++j) bf[ks][j] = *(const bf16x8*)(sb + j * 32 * 64 + ch); } \
        _Pragma("unroll") for (int m = 0; m < 4 * TI; ++m) { \
            const int ks = m / (2 * TI), i = (m % (2 * TI)) >> 1, j = m & 1; \
            if (SWAP) acc[i * 2 + j] = MFMA32(af[ks][i], bf[ks][j], acc[i * 2 + j]); \
            else      acc[j * TI + i] = MFMA32(bf[ks][j], af[ks][i], acc[j * TI + i]); \
            if (DO_ISSUE && (m & 1) && (m >> 1) < NA + 2) { const int q = m >> 1; \
                __builtin_amdgcn_sched_barrier(0); \
                if (q < NA) dma16s(A, pa + (q * 64 * 1024 + _ko) * 2, _sbase + q * 4096); \
                else dma16s(W, pb + ((q - NA) * 64 * 1024 + _ko) * 2, _sbase + MT * 64 + (q - NA) * 4096); \
                __builtin_amdgcn_sched_barrier(0); } } \
        rs = (rs + 1 == NST) ? 0 : rs + 1; } while (0)
    if (TI == 2) {
        if (!pre_issued) { GEMM_ISSUE(0, 0); GEMM_ISSUE(1, 1); }
        int rs = 0, is = 2;
#pragma unroll 1
        for (int kp = 0; kp < KT / 2 - 1; ++kp) {
            WAIT_BAR(0);
            GEMM_STAGE(true, 2 * kp + 2);
            is = (is + 1) & 3;
            GEMM_STAGE(true, 2 * kp + 3);
            is = (is + 1) & 3;
        }
        WAIT_BAR(0);
        GEMM_STAGE(false, 0);
        GEMM_STAGE(false, 0);
    } else {
    if (!pre_issued) {
#pragma unroll
        for (int s = 0; s < NST - 1; ++s) GEMM_ISSUE(s, s);
    }
    int rs = 0, is = NST - 1;
#pragma unroll 1
    for (int kt = 0; kt < KT - (NST - 1); ++kt) {
        if (TI == 4) WAIT_BAR(6); else WAIT_BAR(8);
        GEMM_STAGE(true, kt + NST - 1);
        is = (is + 1 == NST) ? 0 : is + 1;
    }
#pragma unroll 1
    for (int kt = KT - (NST - 1); kt < KT; ++kt) {
        WAIT_BAR(0);
        GEMM_STAGE(false, 0);
    }
    }
#undef GEMM_STAGE
#undef GEMM_ISSUE
}

template <int TI>
DI void gemm_prefetch(const bf16_t* __restrict__ A, const bf16_t* __restrict__ W, int row0, int col0, char* lds) {
    constexpr int MT = 64 * TI, STAGE = (MT + 128) * 64, NST = (TI == 4) ? 3 : 4, NA = TI;
    const int tid = otid(), lane = tid & 63, w = __builtin_amdgcn_readfirstlane(tid >> 6);
    const int cc = (lane & 3) ^ ((lane >> 4) & 3);
    const unsigned pa = (unsigned)(((row0 + 16 * w + (lane >> 2)) * 1024 + cc * 8) * 2);
    const unsigned pb = (unsigned)(((col0 + 16 * w + (lane >> 2)) * 1024 + cc * 8) * 2);
    const unsigned l3 = (unsigned)(size_t)lds + w * 1024;
    asm volatile("s_waitcnt lgkmcnt(0)\n\ts_barrier" ::: "memory");
#pragma unroll
    for (int s = 0; s < ((TI == 2) ? 2 : NST - 1); ++s) {
        const unsigned sb = l3 + s * STAGE; const int ko = s * 32;
#pragma unroll
        for (int j = 0; j < NA; ++j) dma16s(A, pa + (j * 64 * 1024 + ko) * 2, sb + j * 4096);
#pragma unroll
        for (int j = 0; j < 2; ++j) dma16s(W, pb + (j * 64 * 1024 + ko) * 2, sb + MT * 64 + j * 4096);
    }
}

DI void store_pair16(bf16_t* pairp  , int hh, unsigned a0, unsigned a1, unsigned b0, unsigned b1) {
    const u32x2 r0 = __builtin_amdgcn_permlane32_swap(a0, b0, false, false);
    const u32x2 r1 = __builtin_amdgcn_permlane32_swap(a1, b1, false, false);
    *(u32x4*)(pairp + 8 * hh) = (u32x4){r0[0], r1[0], r0[1], r1[1]};
}

template <int TR, int TI>
DI void epi_plain(const f32x16 (&acc)[2 * TI], bf16_t* dst, int stride, int row0) {
    const int lane = otid() & 63, w = __builtin_amdgcn_readfirstlane(otid() >> 6), wm = w >> 1, l31 = lane & 31, hh = lane >> 5;
#pragma unroll
    for (int ti = 0; ti < TI; ++ti) {
        const int r = row0 + wm * (32 * TI) + 32 * ti + l31;
        bf16_t* rp = dst + (size_t)r * stride;
#pragma unroll
        for (int fi = 0; fi < 2; ++fi)
#pragma unroll
            for (int gp = 0; gp < 2; ++gp) {
                float v[8];
#pragma unroll
                for (int e = 0; e < 8; ++e) { float x = acc[fi * TI + ti][8 * gp + e]; if (TR == 1) x = silu_f(x); if (TR == 2) x *= 0.125f; v[e] = x; }
                store_pair16(rp + 32 * fi + 16 * gp, hh, pk2(v[0], v[1]), pk2(v[2], v[3]), pk2(v[4], v[5]), pk2(v[6], v[7]));
            }
    }
}

template <bool RMS, bool ISQ, int TI>
DI void epi_qk(const Params& p, const f32x16 (&acc)[2 * TI], const float* gain, int row0, bf16_t* qdst  , int kslot, int nkv) {
    const int lane = otid() & 63, w = __builtin_amdgcn_readfirstlane(otid() >> 6), wm = w >> 1, l31 = lane & 31, hh = lane >> 5;
#pragma unroll
    for (int ti = 0; ti < TI; ++ti) {
        const int r = row0 + wm * (32 * TI) + 32 * ti + l31;
        const int b = r / TB, t = r - b * TB;
        float v[2][16];
#pragma unroll
        for (int fi = 0; fi < 2; ++fi)
#pragma unroll
            for (int e = 0; e < 16; ++e) v[fi][e] = acc[fi * TI + ti][e];
        if (RMS) {
            float ss = 0.f;
#pragma unroll
            for (int fi = 0; fi < 2; ++fi)
#pragma unroll
                for (int e = 0; e < 16; ++e) ss += v[fi][e] * v[fi][e];
            ss += __shfl_xor(ss, 32);
            const float rstd = rsqrtf(ss * (1.0f / 64.0f) + EPS);
#pragma unroll
            for (int fi = 0; fi < 2; ++fi)
#pragma unroll
                for (int g = 0; g < 4; ++g) {
                    const f32x4 gg = *(const f32x4*)(gain + 32 * fi + 8 * g + 4 * hh);
#pragma unroll
                    for (int e = 0; e < 4; ++e) v[fi][4 * g + e] = v[fi][4 * g + e] * rstd * gg[e];
                }
        }
        if (t >= CTX) {
            const float* rt = p.rope + (size_t)(t - CTX) * 64;
#pragma unroll
            for (int fi = 0; fi < 2; ++fi)
#pragma unroll
                for (int g = 0; g < 4; ++g) {
                    const f32x4 cs = *(const f32x4*)(rt + (16 * fi + 4 * g + 2 * hh) * 2);
                    const float x0 = v[fi][4 * g + 0], x1 = v[fi][4 * g + 1], x2 = v[fi][4 * g + 2], x3 = v[fi][4 * g + 3];
                    v[fi][4 * g + 0] = x0 * cs[0] - x1 * cs[1];
                    v[fi][4 * g + 1] = x0 * cs[1] + x1 * cs[0];
                    v[fi][4 * g + 2] = x2 * cs[2] - x3 * cs[3];
                    v[fi][4 * g + 3] = x2 * cs[3] + x3 * cs[2];
                }
        }
        bf16_t* rp = ISQ ? (qdst + (size_t)r * 1024) : (p.kbuf + ((size_t)(b * nkv + kslot) * TB + t) * 64);
#pragma unroll
        for (int fi = 0; fi < 2; ++fi)
#pragma unroll
            for (int gp = 0; gp < 2; ++gp) {
                float o[8];
#pragma unroll
                for (int e = 0; e < 8; ++e) o[e] = ISQ ? v[fi][8 * gp + e] * 0.125f : v[fi][8 * gp + e];
                store_pair16(rp + 32 * fi + 16 * gp, hh, pk2(o[0], o[1]), pk2(o[2], o[3]), pk2(o[4], o[5]), pk2(o[6], o[7]));
            }
    }
}

template <int TI>
DI void epi_k_plain(const Params& p, const f32x16 (&acc)[2 * TI], int row0, int kslot, int nkv) {
    const int lane = otid() & 63, w = __builtin_amdgcn_readfirstlane(otid() >> 6), wm = w >> 1, l31 = lane & 31, hh = lane >> 5;
#pragma unroll
    for (int ti = 0; ti < TI; ++ti) {
        const int r = row0 + wm * (32 * TI) + 32 * ti + l31;
        const int b = r / TB, t = r - b * TB;
        bf16_t* rp = p.kbuf + ((size_t)(b * nkv + kslot) * TB + t) * 64;
#pragma unroll
        for (int fi = 0; fi < 2; ++fi)
#pragma unroll
            for (int gp = 0; gp < 2; ++gp)
                store_pair16(rp + 32 * fi + 16 * gp, hh, pk2(acc[fi * TI + ti][8 * gp], acc[fi * TI + ti][8 * gp + 1]), pk2(acc[fi * TI + ti][8 * gp + 2], acc[fi * TI + ti][8 * gp + 3]),
                             pk2(acc[fi * TI + ti][8 * gp + 4], acc[fi * TI + ti][8 * gp + 5]), pk2(acc[fi * TI + ti][8 * gp + 6], acc[fi * TI + ti][8 * gp + 7]));
    }
}

template <int TI>
DI void epi_v(const Params& p, const f32x16 (&acc)[2 * TI], int row0, int vslot, int nkv) {
    const int lane = otid() & 63, w = __builtin_amdgcn_readfirstlane(otid() >> 6), wm = w >> 1, l31 = lane & 31, hh = lane >> 5;
#pragma unroll
    for (int ti = 0; ti < TI; ++ti) {
        const int rb = row0 + wm * (32 * TI) + 32 * ti;
        const int b = rb / TB, tb = rb - b * TB;
#pragma unroll
        for (int fi = 0; fi < 2; ++fi) {
            const int d = 32 * fi + l31;
            bf16_t* vp = p.vT + ((size_t)(b * nkv + vslot) * 64 + d) * TB + tb;
#pragma unroll
            for (int gq = 0; gq < 2; ++gq) {
                u32x4 o;
                o[0] = pk2(acc[ti * 2 + fi][8 * gq + 0], acc[ti * 2 + fi][8 * gq + 1]);
                o[1] = pk2(acc[ti * 2 + fi][8 * gq + 2], acc[ti * 2 + fi][8 * gq + 3]);
                o[2] = pk2(acc[ti * 2 + fi][8 * gq + 4], acc[ti * 2 + fi][8 * gq + 5]);
                o[3] = pk2(acc[ti * 2 + fi][8 * gq + 6], acc[ti * 2 + fi][8 * gq + 7]);
                *(u32x4*)(vp + 16 * gq + 8 * hh) = o;
            }
        }
    }
}

#ifndef GPROBE
#define GPROBE 0
#endif
constexpr int TIN = 4;
DI void gemm_in_phase(const Params& p, int layer, char* lds, const Grp& g, bool do_epi = true) {
    const bool even = (layer & 1) == 0;
    const int j = layer >> 1;
    const int N = even ? 2560 : 3584, nct = N / 128;
    const bf16_t* W = even ? p.wt_ev_in + (size_t)j * 2560 * 1024 : p.wt_od_in + (size_t)j * 3584 * 1024;
    const bool last = (layer == 3);
    const int local = g.local, nlocal = g.nlocal;
    const int wn = __builtin_amdgcn_readfirstlane(otid() >> 6) & 1;
    constexpr int RT_PER_XCD = MROWS / (64 * TIN) / 8;
    const int nli = RT_PER_XCD * nct;
#define GIN_SKIP(li_) (last && ((li_) / nct == 0) && ((((li_) % nct) * 128 < 2048) || (((li_) % nct) * 128 >= 3072)))
    for (int xcd = g.xcd; xcd < NB; xcd += g.nx) {
    int li = local;
    while (li < nli && GIN_SKIP(li)) li += nlocal;
    bool pre = false;
    while (li < nli) {
        const int rtl = li / nct, ct = li - rtl * nct;
        const int rt = xcd * RT_PER_XCD + rtl;
        const int row0 = rt * (64 * TIN), col0 = ct * 128;
        const int c64 = col0 + wn * 64;
        const bool swap = even ? (col0 == 640 || col0 == 1920) : (col0 >= 2560 && col0 < 3072);
        f32x16 acc[2 * TIN];
        if (!do_epi) {
            gemm_mainloop<false, TIN, GPROBE>(p.h, W, row0, col0, acc, lds, false);
            float sm = 0.f;
#pragma unroll
            for (int i = 0; i < 2 * TIN; ++i)
#pragma unroll
                for (int e = 0; e < 16; ++e) sm += acc[i][e];
            if (sm == 12345.678f) p.mvec[0] = sm;
            li += nlocal;
            continue;
        }
        if (swap) gemm_mainloop<true, TIN>(p.h, W, row0, col0, acc, lds, pre);
        else gemm_mainloop<false, TIN>(p.h, W, row0, col0, acc, lds, pre);
        int ln = li + nlocal;
        while (ln < nli && GIN_SKIP(ln)) ln += nlocal;
        pre = ln < nli;
        if (pre) { const int rtl2 = ln / nct, ct2 = ln - rtl2 * nct; gemm_prefetch<TIN>(p.h, W, (xcd * RT_PER_XCD + rtl2) * (64 * TIN), ct2 * 128, lds); }
        li = ln;
        if (even) {
            if (swap) epi_v<TIN>(p, acc, row0, (col0 == 640 ? 0 : 2) + wn, 4);
            else if (col0 < 512) epi_qk<true, true, TIN>(p, acc, p.a_q_gain + j * 64, row0, p.qbuf + c64, 0, 4);
            else if (col0 < 640) epi_qk<true, false, TIN>(p, acc, p.a_k_gain + j * 64, row0, nullptr, wn, 4);
            else if (col0 < 1280) epi_plain<1, TIN>(acc, p.gbuf + (c64 - 768), 1024, row0);
            else if (col0 < 1792) epi_qk<false, true, TIN>(p, acc, nullptr, row0, p.qbuf + 512 + (c64 - 1280), 0, 4);
            else if (col0 < 1920) epi_qk<false, false, TIN>(p, acc, nullptr, row0, nullptr, 2 + wn, 4);
            else epi_plain<1, TIN>(acc, p.gbuf + 512 + (c64 - 2048), 1024, row0);
        } else {
            if (swap) epi_v<TIN>(p, acc, row0, (c64 - 2560) >> 6, 8);
            else if (col0 < 1024) epi_plain<0, TIN>(acc, p.cbuf + c64, 1536, row0);
            else if (col0 < 1536) epi_plain<1, TIN>(acc, p.cbuf + c64, 1536, row0);
            else if (col0 < 2048) epi_plain<2, TIN>(acc, p.qbuf + (c64 - 1536), 512, row0);
            else if (col0 < 2560) epi_k_plain<TIN>(p, acc, row0, (c64 - 2048) >> 6, 8);
            else epi_plain<1, TIN>(acc, p.gbuf + (c64 - 3072), 512, row0);
        }
    }
    }
#undef GIN_SKIP
}

constexpr int TOUT = 2;
DI void gemm_out_phase(const Params& p, int layer, char* lds, const Grp& g) {
    const bool even = (layer & 1) == 0;
    const int j = layer >> 1;
    const bf16_t* W = (even ? p.wt_ev_out : p.wt_od_out) + (size_t)j * 1024 * 1024;
    const bool last = (layer == 3);
    const int local = g.local, nlocal = g.nlocal;
    constexpr int RT_PER_XCD = MROWS / (64 * TOUT) / 8;
    const int nli = RT_PER_XCD * 8;
#define GOUT_SKIP(li_) (last && ((li_) >> 3) < 2)
    for (int xcd = g.xcd; xcd < NB; xcd += g.nx) {
    int li = local;
    while (li < nli && GOUT_SKIP(li)) li += nlocal;
    bool pre = false;
    while (li < nli) {
        const int rtl = li >> 3, ct = li & 7;
        const int rt = xcd * RT_PER_XCD + rtl;
        const int row0 = rt * (64 * TOUT), col0 = ct * 128;
        f32x16 acc[2 * TOUT];
        gemm_mainloop<false, TOUT>(p.h  , W, row0, col0, acc, lds, pre);
        int ln = li + nlocal;
        while (ln < nli && GOUT_SKIP(ln)) ln += nlocal;
        pre = ln < nli;
        if (pre) gemm_prefetch<TOUT>(p.h, W, (xcd * RT_PER_XCD + (ln >> 3)) * (64 * TOUT), (ln & 7) * 128, lds);
        li = ln;
        const int lane = otid() & 63, w = __builtin_amdgcn_readfirstlane(otid() >> 6), wm = w >> 1, wn = w & 1, l31 = lane & 31, hh = lane >> 5;
#pragma unroll
        for (int ti = 0; ti < TOUT; ++ti) {
            const int r = row0 + wm * (32 * TOUT) + 32 * ti + l31;
            const int b = r / TB, t = r - b * TB;
            const int cond = (t < CTX) ? 8 : b;
            const float* gm = p.mvec + ((size_t)layer * 9 + cond) * 3072 + 2048;
            const float* xi = res_in_row(p, layer, r);
            float* xo = res_out_row(p, r);
#pragma unroll
            for (int fi = 0; fi < 2; ++fi)
#pragma unroll
                for (int g = 0; g < 4; ++g) {
                    const int c = col0 + wn * 64 + 32 * fi + 8 * g + 4 * hh;
                    const f32x4 xv = *(const f32x4*)(xi + c), gv = *(const f32x4*)(gm + c);
                    f32x4 o;
#pragma unroll
                    for (int e = 0; e < 4; ++e) o[e] = xv[e] + gv[e] * acc[fi * TOUT + ti][4 * g + e];
                    *(f32x4*)(xo + c) = o;
                }
        }
    }
    }
#undef GOUT_SKIP
}

template <int MODE>
DI void attn_block(char* lds, const bf16_t* __restrict__ Kb, const bf16_t* __restrict__ Vb, int nt, int lat_lo,
                   const bf16_t* __restrict__ qptr, int qstride, const bf16_t* __restrict__ gptr, int gstride, bf16_t* __restrict__ optr,
                   float sink_l2, int tq_base, const float* rpb_lds, int rq) {
    constexpr int ASTAGE = 16384, ANST = 3;
    const int tid = otid(), lane = tid & 63, w = __builtin_amdgcn_readfirstlane(tid >> 6), l31 = lane & 31, hh = lane >> 5;
    const int r8 = lane >> 3;
    const int cc = (lane & 7) ^ (4 * (w & 1) + (r8 >> 1));
    const unsigned kp = (unsigned)(((8 * w + r8) * 64 + cc * 8) * 2);
    const unsigned vp = (unsigned)(((8 * w + r8) * TB + cc * 8) * 2);
    const unsigned l3 = (unsigned)(size_t)lds + w * 1024;
#define ATT_ISSUE(itile, st) do { const int _t0 = ((itile) < 4) ? (itile) * 64 : CTX + lat_lo + ((itile) - 4) * 64; const unsigned _sb = l3 + (st) * ASTAGE; \
        dma16s(Kb, kp + _t0 * 128, _sb); dma16s(Kb, kp + (_t0 + 32) * 128, _sb + 4096); \
        dma16s(Vb, vp + _t0 * 2, _sb + 8192); dma16s(Vb, vp + (32 * TB + _t0) * 2, _sb + 8192 + 4096); } while (0)
    WAIT_BAR(0);
    ATT_ISSUE(0, 0);
    ATT_ISSUE(1, 1);
    bf16x8 qf[4];
#pragma unroll
    for (int ks = 0; ks < 4; ++ks) qf[ks] = *(const bf16x8*)(qptr + (size_t)l31 * qstride + 16 * ks + 8 * hh);
    asm volatile("" :: "v"(qf[0]), "v"(qf[1]), "v"(qf[2]), "v"(qf[3]));
    f32x16 O0, O1;
#pragma unroll
    for (int e = 0; e < 16; ++e) { O0[e] = 0.f; O1[e] = 0.f; }
    float mrun = (MODE == 1) ? sink_l2 : -1e30f;
    f32x16 Lacc;
#pragma unroll
    for (int e = 0; e < 16; ++e) Lacc[e] = (MODE == 1) ? 1.f : 0.f;
    const bf16x8 ones = __builtin_bit_cast(bf16x8, (u32x4){0x3F803F80u, 0x3F803F80u, 0x3F803F80u, 0x3F803F80u});
    const int tq = tq_base + l31;
    int cq = 0, cs_ = 0, rs = 0;
    if (MODE == 2) { cq = tq & 63; cs_ = min(max(cq - 8, 0), 48); rs = min(max(rq - 4, 0), 24); }
    const int swz = (l31 >> 1) & 7;
    const char* kbase = lds + l31 * 128;
    const char* vbase = lds + 8192 + l31 * 128;
    int rst = 0, ist = 2;
    if (MODE == 0) {
#define T15_QK(N0, N1, SLOT) do { const char* _k = kbase + (SLOT) * ASTAGE; \
            _Pragma("unroll") for (int e = 0; e < 16; ++e) { N0[e] = 0.f; N1[e] = 0.f; } \
            _Pragma("unroll") for (int ks = 0; ks < 4; ++ks) { const int ch = ((2 * ks + hh) ^ swz) * 16; \
                const bf16x8 k0 = *(const bf16x8*)(_k + ch), k1 = *(const bf16x8*)(_k + 32 * 128 + ch); \
                N0 = MFMA32(k0, qf[ks], N0); N1 = MFMA32(k1, qf[ks], N1); } } while (0)
#define T15_STEP(C0, C1, N0, N1, IT) do { \
            WAIT_BAR(0);                                     \
            if ((IT) + 2 < nt) { ATT_ISSUE((IT) + 2, ist); ist = (ist == 2) ? 0 : ist + 1; } \
            const char* ldsV = vbase + rst * ASTAGE; \
            rst = (rst == 2) ? 0 : rst + 1; \
            float mx = max3f(C0[0], C1[0], C0[1]); \
            _Pragma("unroll") for (int e = 1; e < 15; ++e) mx = max3f(mx, C1[e], C0[e + 1]); \
            mx = max3f(mx, C1[15], C1[15]) * LOG2E; \
            if (__any(mx > mrun + 8.0f)) { \
                const float mnew = max3f(mrun, mx, __shfl_xor(mx, 32)); \
                const float alpha = __builtin_amdgcn_exp2f(mrun - mnew); \
                _Pragma("unroll") for (int e = 0; e < 16; ++e) { O0[e] *= alpha; O1[e] *= alpha; Lacc[e] *= alpha; } \
                mrun = mnew; } \
            if ((IT) + 1 < nt) T15_QK(N0, N1, rst);          \
            _Pragma("unroll") for (int e = 0; e < 16; ++e) { \
                C0[e] = __builtin_amdgcn_exp2f(__builtin_fmaf(C0[e], LOG2E, -mrun)); \
                C1[e] = __builtin_amdgcn_exp2f(__builtin_fmaf(C1[e], LOG2E, -mrun)); } \
            if ((IT) + 1 < nt) { __builtin_amdgcn_sched_group_barrier(0x100, 8, 0); \
                _Pragma("unroll") for (int _g = 0; _g < 8; ++_g) { __builtin_amdgcn_sched_group_barrier(0x008, 1, 0); __builtin_amdgcn_sched_group_barrier(0x002, 8, 0); } } \
            _Pragma("unroll") for (int sub = 0; sub < 2; ++sub) \
            _Pragma("unroll") for (int sx = 0; sx < 2; ++sx) { \
                u32x4 pa; \
                if (sub == 0) { pa[0] = pk2(C0[8 * sx + 0], C0[8 * sx + 1]); pa[1] = pk2(C0[8 * sx + 2], C0[8 * sx + 3]); pa[2] = pk2(C0[8 * sx + 4], C0[8 * sx + 5]); pa[3] = pk2(C0[8 * sx + 6], C0[8 * sx + 7]); } \
                else          { pa[0] = pk2(C1[8 * sx + 0], C1[8 * sx + 1]); pa[1] = pk2(C1[8 * sx + 2], C1[8 * sx + 3]); pa[2] = pk2(C1[8 * sx + 4], C1[8 * sx + 5]); pa[3] = pk2(C1[8 * sx + 6], C1[8 * sx + 7]); } \
                const bf16x8 pfr = __builtin_bit_cast(bf16x8, pa); \
                const int ch = ((2 * (2 * sub + sx) + hh) ^ swz) * 16; \
                const bf16x8 v0 = *(const bf16x8*)(ldsV + ch), v1 = *(const bf16x8*)(ldsV + 32 * 128 + ch); \
                O0 = MFMA32(v0, pfr, O0); O1 = MFMA32(v1, pfr, O1); Lacc = MFMA32(ones, pfr, Lacc); } } while (0)
        f32x16 a0, a1, b0, b1;
        WAIT_BAR(4);
        T15_QK(a0, a1, 0);
#pragma unroll 1
        for (int it = 0; it < nt; it += 2) {
            T15_STEP(a0, a1, b0, b1, it);
            T15_STEP(b0, b1, a0, a1, it + 1);
        }
#undef T15_STEP
#undef T15_QK
    } else
#pragma unroll 1
    for (int it = 0; it < nt; ++it) {
        if (it + 1 < nt) WAIT_BAR(4); else WAIT_BAR(0);
        if (it + 2 < nt) { ATT_ISSUE(it + 2, ist); ist = (ist == 2) ? 0 : ist + 1; }
        const char* ldsK = kbase + rst * ASTAGE;
        const char* ldsV = vbase + rst * ASTAGE;
        rst = (rst == 2) ? 0 : rst + 1;
        bool active = true;
        int krow = 0;
        if (MODE == 2 && it >= 4) { krow = (lat_lo >> 6) + it - 4; active = (krow >= rs) && (krow < rs + 8); }
        if (active) {
            f32x16 s0, s1;
#pragma unroll
            for (int e = 0; e < 16; ++e) { s0[e] = 0.f; s1[e] = 0.f; }
            bf16x8 kf[2][4];
#pragma unroll
            for (int ks = 0; ks < 4; ++ks) {
                const int ch = ((2 * ks + hh) ^ swz) * 16;
                kf[0][ks] = *(const bf16x8*)(ldsK + ch);
                kf[1][ks] = *(const bf16x8*)(ldsK + 32 * 128 + ch);
            }
#pragma unroll
            for (int ks = 0; ks < 4; ++ks) {
                s0 = MFMA32(kf[0][ks], qf[ks], s0);
                s1 = MFMA32(kf[1][ks], qf[ks], s1);
            }
            bf16x8 vf[2][4];
#pragma unroll
            for (int q = 0; q < 4; ++q) {
                const int ch = ((2 * q + hh) ^ swz) * 16;
                vf[0][q] = *(const bf16x8*)(ldsV + ch);
                vf[1][q] = *(const bf16x8*)(ldsV + 32 * 128 + ch);
            }
            if (MODE != 2) {
                __builtin_amdgcn_sched_group_barrier(0x100, 8, 0);
                __builtin_amdgcn_sched_group_barrier(0x008, 8, 0);
                __builtin_amdgcn_sched_group_barrier(0x100, 8, 0);
            }
            if (MODE == 1 && it >= 4) {
                const int base = lat_lo + (it - 4) * 64 + 4 * hh - tq + 128;
#pragma unroll
                for (int e = 0; e < 16; ++e) {
                    const int o = (e >> 2) * 8 + (e & 3);
                    s0[e] = ((unsigned)(base + o) <= 256u) ? s0[e] : -1e30f;
                    s1[e] = ((unsigned)(base + 32 + o) <= 256u) ? s1[e] : -1e30f;
                }
            } else if (MODE == 2 && it >= 4) {
                const float* rpl = rpb_lds + (krow - rq + 7) * 31 + (4 * hh - cq + 15);
                const int vt = 4 * hh - cs_;
#pragma unroll
                for (int e = 0; e < 16; ++e) {
                    const int kcst = (e >> 2) * 8 + (e & 3);
                    const float b0 = rpl[kcst], b1 = rpl[kcst + 32];
                    s0[e] = ((unsigned)(kcst + vt) < 16u) ? (s0[e] + b0) : -1e30f;
                    s1[e] = ((unsigned)(kcst + 32 + vt) < 16u) ? (s1[e] + b1) : -1e30f;
                }
            }
            float mx = max3f(s0[0], s1[0], s0[1]);
#pragma unroll
            for (int e = 1; e < 15; ++e) mx = max3f(mx, s1[e], s0[e + 1]);
            mx = max3f(mx, s1[15], s1[15]) * LOG2E;
            if (__any(mx > mrun + 8.0f)) {
                const float mnew = max3f(mrun, mx, __shfl_xor(mx, 32));
                const float alpha = __builtin_amdgcn_exp2f(mrun - mnew);
#pragma unroll
                for (int e = 0; e < 16; ++e) { O0[e] *= alpha; O1[e] *= alpha; Lacc[e] *= alpha; }
                mrun = mnew;
            }
#pragma unroll
            for (int e = 0; e < 16; ++e) {
                s0[e] = __builtin_amdgcn_exp2f(__builtin_fmaf(s0[e], LOG2E, -mrun));
                s1[e] = __builtin_amdgcn_exp2f(__builtin_fmaf(s1[e], LOG2E, -mrun));
            }
            bf16x8 pf[2][2];
#pragma unroll
            for (int s = 0; s < 2; ++s) {
                u32x4 a, b;
                a[0] = pk2(s0[8 * s + 0], s0[8 * s + 1]); a[1] = pk2(s0[8 * s + 2], s0[8 * s + 3]); a[2] = pk2(s0[8 * s + 4], s0[8 * s + 5]); a[3] = pk2(s0[8 * s + 6], s0[8 * s + 7]);
                b[0] = pk2(s1[8 * s + 0], s1[8 * s + 1]); b[1] = pk2(s1[8 * s + 2], s1[8 * s + 3]); b[2] = pk2(s1[8 * s + 4], s1[8 * s + 5]); b[3] = pk2(s1[8 * s + 6], s1[8 * s + 7]);
                pf[0][s] = __builtin_bit_cast(bf16x8, a); pf[1][s] = __builtin_bit_cast(bf16x8, b);
            }
#pragma unroll
            for (int sub = 0; sub < 2; ++sub)
#pragma unroll
                for (int s = 0; s < 2; ++s) {
                    O0 = MFMA32(vf[0][2 * sub + s], pf[sub][s], O0);
                    O1 = MFMA32(vf[1][2 * sub + s], pf[sub][s], O1);
                    Lacc = MFMA32(ones, pf[sub][s], Lacc);
                }
        }
    }
#undef ATT_ISSUE
    const float inv = 1.0f / Lacc[0];
    const bf16_t* gp = gptr + (size_t)l31 * gstride;
    bf16_t* op = optr + (size_t)l31 * 1024;
#pragma unroll
    for (int half = 0; half < 2; ++half)
#pragma unroll
        for (int pr = 0; pr < 2; ++pr) {
            unsigned pk[4];
#pragma unroll
            for (int q = 0; q < 2; ++q) {
                const int g = 2 * pr + q, d = 32 * half + 8 * g + 4 * hh;
                const u32x2 gg = *(const u32x2*)(gp + d);
                const float a0 = (half ? O1[4 * g] : O0[4 * g]), a1 = (half ? O1[4 * g + 1] : O0[4 * g + 1]), a2 = (half ? O1[4 * g + 2] : O0[4 * g + 2]), a3 = (half ? O1[4 * g + 3] : O0[4 * g + 3]);
                pk[2 * q] = pk2(a0 * inv * bf_lo(gg[0]), a1 * inv * bf_hi(gg[0]));
                pk[2 * q + 1] = pk2(a2 * inv * bf_lo(gg[1]), a3 * inv * bf_hi(gg[1]));
            }
            store_pair16(op + 32 * half + 16 * pr, hh, pk[0], pk[1], pk[2], pk[3]);
        }
}

DI void even_mix_phase(const Params& p, int layer, char* lds, const Grp& g) {
    const int j = layer >> 1;
    const bool upd = layer < 3;
    const int w = __builtin_amdgcn_readfirstlane(otid() >> 6);
    const int local = g.local, nlocal = g.nlocal;
    const int per_b = 256 + (upd ? 32 : 0);
    for (int xcd = g.xcd; xcd < NB; xcd += g.nx)
    for (int li = local; li < per_b; li += nlocal) {
        const int item = (li < 128) ? (xcd * 128 + li) : (li < 256) ? (1024 + xcd * 128 + (li - 128)) : (2048 + xcd * 32 + (li - 256));
        if (item < 2048) {
            const bool isB = item >= 1024;
            const int it2 = item & 1023;
            const int b = it2 >> 7, kvh = (it2 >> 6) & 1, qt = it2 & 63;
            const int slot = (isB ? 2 : 0) + kvh;
            const int head = kvh * 4 + w;
            const int col = (isB ? 512 : 0) + head * 64;
            const int r0 = b * TB + CTX + qt * 32;
            const bf16_t* Kb = p.kbuf + (size_t)(b * 4 + slot) * TB * 64;
            const bf16_t* Vb = p.vT + (size_t)(b * 4 + slot) * 64 * TB;
            const bf16_t* qp = p.qbuf + (size_t)r0 * 1024 + col;
            const bf16_t* gp = p.gbuf + (size_t)r0 * 1024 + col;
            bf16_t* op = p.h + (size_t)r0 * 1024 + col;
            if (!isB) attn_block<0>(lds, Kb, Vb, 36, 0, qp, 1024, gp, 1024, op, 0.f, qt * 32, nullptr, 0);
            else {
                const int q0 = qt * 32;
                const int lo = max(0, q0 - 128) & ~63;
                const int hi = (min(SEQ, q0 + 160) + 63) & ~63;
                attn_block<1>(lds, Kb, Vb, 4 + ((hi - lo) >> 6), lo, qp, 1024, gp, 1024, op, p.b_sink[j * 8 + head] * LOG2E, q0, nullptr, 0);
            }
        } else {
            const int idx = item - 2048;
            const int b = idx >> 5, slot = (idx >> 3) & 3, qt = idx & 7;
            const bool isB = slot >= 2;
            const int head = (slot & 1) * 4 + w;
            const int col = (isB ? 512 : 0) + head * 64;
            const int r0 = b * TB + qt * 32;
            const bf16_t* Kb = p.kbuf + (size_t)(b * 4 + slot) * TB * 64;
            const bf16_t* Vb = p.vT + (size_t)(b * 4 + slot) * 64 * TB;
            const bf16_t* qp = p.qbuf + (size_t)r0 * 1024 + col;
            const bf16_t* gp = p.gbuf + (size_t)r0 * 1024 + col;
            bf16_t* op = p.h + (size_t)r0 * 1024 + col;
            if (!isB) attn_block<0>(lds, Kb, Vb, 4, 0, qp, 1024, gp, 1024, op, 0.f, 0, nullptr, 0);
            else attn_block<1>(lds, Kb, Vb, 4, 0, qp, 1024, gp, 1024, op, p.b_sink[j * 8 + head] * LOG2E, 0, nullptr, 0);
        }
    }
}

constexpr int CT = 16;
DI void conv_item(const Params& p, int j, int rbase  , int seglen, int t0, char* lds) {
    const int tid = otid(), lane = tid & 63, w = tid >> 6;
    const int c = 2 * tid;
    float wt[31][2];
    const float* wb = p.c_dw_w + (size_t)j * 31 * 512 + c;
    const bf16_t* cb = p.cbuf + (size_t)rbase * 1536 + c;
    asm volatile("" : "+v"(wb));
    asm volatile("" : "+v"(cb));
#pragma unroll
    for (int k = 0; k < 31; ++k) { const f32x2 v = *(const f32x2*)(wb + k * 512); wt[k][0] = v[0]; wt[k][1] = v[1]; }
    const f32x2 bias = *(const f32x2*)(p.c_dw_b + j * 512 + c);
    float acc[CT][2];
#pragma unroll
    for (int o = 0; o < CT; ++o) { acc[o][0] = bias[0]; acc[o][1] = bias[1]; }
#pragma unroll
    for (int i = 0; i < CT + 30; ++i) {
        const int pos = t0 - 15 + i;
        float u0 = 0.f, u1 = 0.f;
        if (pos >= 0 && pos < seglen) {
            const bf16_t* rp = cb + (ptrdiff_t)pos * 1536;
            const unsigned a = *(const unsigned*)rp, g = *(const unsigned*)(rp + 512);
            u0 = bf_lo(a) * sigmoid_f(bf_lo(g)); u1 = bf_hi(a) * sigmoid_f(bf_hi(g));
        }
#pragma unroll
        for (int o = 0; o < CT; ++o) {
            const int k = i - o;
            if (k >= 0 && k < 31) { acc[o][0] += wt[k][0] * u0; acc[o][1] += wt[k][1] * u1; }
        }
    }
    float* red = (float*)lds;
    float* stat = red + CT * 8;
    __syncthreads();
#pragma unroll
    for (int o = 0; o < CT; ++o) {
        float s1 = acc[o][0] + acc[o][1], s2 = acc[o][0] * acc[o][0] + acc[o][1] * acc[o][1];
#pragma unroll
        for (int sh = 32; sh >= 1; sh >>= 1) { s1 += __shfl_xor(s1, sh); s2 += __shfl_xor(s2, sh); }
        if (lane == 0) { red[(o * 4 + w) * 2] = s1; red[(o * 4 + w) * 2 + 1] = s2; }
    }
    __syncthreads();
    if (tid < CT) {
        float s1 = 0.f, s2 = 0.f;
#pragma unroll
        for (int q = 0; q < 4; ++q) { s1 += red[(tid * 4 + q) * 2]; s2 += red[(tid * 4 + q) * 2 + 1]; }
        const float mean = s1 * (1.0f / 512.0f);
        const float var = fmaxf(s2 * (1.0f / 512.0f) - mean * mean, 0.f);
        stat[tid * 2] = mean; stat[tid * 2 + 1] = rsqrtf(var + EPS);
    }
    __syncthreads();
    const f32x2 lg = *(const f32x2*)(p.c_ln_g + j * 512 + c), lb = *(const f32x2*)(p.c_ln_b + j * 512 + c);
#pragma unroll
    for (int o = 0; o < CT; ++o) {
        const f32x2 st = *(const f32x2*)(stat + 2 * o);
        const float mean = st[0], rstd = st[1];
        const size_t r = (size_t)(rbase + t0 + o);
        const unsigned sg = *(const unsigned*)(cb + (ptrdiff_t)(t0 + o) * 1536 + 1024);
        const float y0 = silu_f((acc[o][0] - mean) * rstd * lg[0] + lb[0]) * bf_lo(sg);
        const float y1 = silu_f((acc[o][1] - mean) * rstd * lg[1] + lb[1]) * bf_hi(sg);
        *(unsigned*)(p.h + r * 1024 + c) = pk2(y0, y1);
    }
}

DI void odd_mix_phase(const Params& p, int layer, char* lds, const Grp& g) {
    const int j = layer >> 1;
    const bool upd = layer < 3;
    const int tid = otid(), w = __builtin_amdgcn_readfirstlane(tid >> 6);
    constexpr int NCL = NB * SEQ / CT, NCC = NB * CTX / CT, I1 = 1024 + NCL, I2 = I1 + 128;
    const int total = I1 + (upd ? 128 + NCC : 0); (void)total;
    const int local = g.local, nlocal = g.nlocal;
    constexpr int PCL = NCL / NB, PCC = NCC / NB;
    const int per_b = 128 + PCL + (upd ? 16 + PCC : 0);
    float* rpb_lds = (float*)(lds + 3 * 16384) + 64;
    for (int xcd = g.xcd; xcd < NB; xcd += g.nx)
    for (int li = local; li < per_b; li += nlocal) {
        const int item = (li < 128) ? (xcd * 128 + li) : (li < 128 + PCL) ? (1024 + xcd * PCL + (li - 128)) : (li < 128 + PCL + 16) ? (I1 + xcd * 16 + (li - 128 - PCL)) : (I2 + xcd * PCC + (li - 128 - PCL - 16));
        if (item < 1024) {
            const int b = item >> 7, hd = (item >> 4) & 7, rp = item & 15;
            __syncthreads();
            for (int i = tid; i < 465 + 128; i += 256) { const int k = i - 64; rpb_lds[k] = (k >= 0 && k < 465) ? p.d_rpb[((size_t)j * 8 + hd) * 465 + k] : 0.f; }
            const int rq = 2 * rp + (w >> 1);
            const int lo_row = min(max(2 * rp - 4, 0), 24), hi_row = min(max(2 * rp + 1 - 4, 0), 24) + 8;
            const int tq0 = rq * 64 + (w & 1) * 32;
            const int r0 = b * TB + CTX + tq0;
            const bf16_t* Kb = p.kbuf + (size_t)(b * 8 + hd) * TB * 64;
            const bf16_t* Vb = p.vT + (size_t)(b * 8 + hd) * 64 * TB;
            attn_block<2>(lds, Kb, Vb, 4 + (hi_row - lo_row), lo_row * 64, p.qbuf + (size_t)r0 * 512 + hd * 64, 512, p.gbuf + (size_t)r0 * 512 + hd * 64, 512,
                          p.h + (size_t)r0 * 1024 + 512 + hd * 64, 0.f, tq0, rpb_lds, rq);
        } else if (item >= I1 && item < I2) {
            const int idx = item - I1, b = idx >> 4, hd = (idx >> 1) & 7, half = idx & 1;
            const int r0 = b * TB + half * 128 + w * 32;
            const bf16_t* Kb = p.kbuf + (size_t)(b * 8 + hd) * TB * 64;
            const bf16_t* Vb = p.vT + (size_t)(b * 8 + hd) * 64 * TB;
            attn_block<0>(lds, Kb, Vb, 4, 0, p.qbuf + (size_t)r0 * 512 + hd * 64, 512, p.gbuf + (size_t)r0 * 512 + hd * 64, 512,
                          p.h + (size_t)r0 * 1024 + 512 + hd * 64, 0.f, 0, nullptr, 0);
        } else {
            int rbase, seglen, t0;
            if (item < I1) { const int idx = item - 1024; rbase = (idx / (SEQ / CT)) * TB + CTX; seglen = SEQ; t0 = (idx % (SEQ / CT)) * CT; }
            else { const int idx = item - I2; rbase = (idx / (CTX / CT)) * TB; seglen = CTX; t0 = (idx % (CTX / CT)) * CT; }
            conv_item(p, j, rbase, seglen, t0, lds);
        }
    }
}

#ifndef PMASK
#define PMASK 0xff
#endif
DI void run_phase(const Params& p, int ph, char* lds, const Grp& g) {
    if (ph == 0) { phase0(p, lds); return; }
    if (ph == 17) { final_phase(p, g); return; }
    const int layer = (ph - 1) >> 2, sub = (ph - 1) & 3;
    if (sub == 0) norm_phase(p, layer, g);
    else if (sub == 1) gemm_in_phase(p, layer, lds, g);
    else if (sub == 2) { if (layer & 1) odd_mix_phase(p, layer, lds, g); else even_mix_phase(p, layer, lds, g); }
    else gemm_out_phase(p, layer, lds, g);
}

__global__ void __launch_bounds__(256, 2) fwd_kernel(Params p, int ph0, int ph1) {
    __shared__ __attribute__((aligned(16))) char lds[LDS_BYTES];
    __shared__ uint4 xb_words;
    XcdBarrier xb;
    const bool multi = (ph1 - ph0) > 1;
    Grp g; g.xcd = blockIdx.x & 7; g.local = blockIdx.x >> 3; g.nlocal = gridDim.x >> 3; g.nx = 8;
    if (multi) {
        if (threadIdx.x == 0) xb_words = make_uint4(0u, 0u, 0u, 0u);
        __syncthreads();
        xb = xcd_barrier_post(p.bar, (volatile LAS unsigned*)&xb_words);
    }
#ifdef CLOCK_PROBE
    const unsigned long long ct0 = __builtin_amdgcn_s_memtime(), cr0 = __builtin_amdgcn_s_memrealtime();
#endif
    for (int ph = ph0; ph < ph1; ++ph) {
        if (ph > ph0) {
            if (ph == ph0 + 1) {
                xcd_barrier(xb);
                g.nlocal = (int)xb.st[0]; g.nx = (int)xb.st[1]; g.xcd = (int)xb.st[2]; g.local = (int)xb.st[3];
            } else xcc_barrier(xb);
        }
        run_phase(p, ph, lds, g);
    }
#ifdef CLOCK_PROBE
    if (blockIdx.x == 0 && threadIdx.x == 0) {
        const unsigned long long ct1 = __builtin_amdgcn_s_memtime(), cr1 = __builtin_amdgcn_s_memrealtime();
        const unsigned long long mhz = (ct1 - ct0) * 100ull / (cr1 - cr0 + 1ull);
        const unsigned long long extra = mhz * 10ull;
        while (__builtin_amdgcn_s_memrealtime() - cr1 < extra) __builtin_amdgcn_s_sleep(8);
    }
#endif
}

extern "C" void kernel_launch(void* const* d_in, const int* in_sizes, int n_in, void* d_out, int out_size, void* d_ws, size_t ws_size, hipStream_t stream) {
    Params p{};
    p.x = (const float*)d_in[0]; p.c = (const float*)d_in[1]; p.ctx = (const float*)d_in[2]; p.c_ctx = (const float*)d_in[3];
    p.mod_w = (const float*)d_in[4]; p.mod_b = (const float*)d_in[5]; p.norm_g = (const float*)d_in[6];
    p.ev_w_in = (const float*)d_in[7]; p.ev_w_out = (const float*)d_in[8]; p.a_q_gain = (const float*)d_in[9]; p.a_k_gain = (const float*)d_in[10]; p.b_sink = (const float*)d_in[11];
    p.od_w_in = (const float*)d_in[12]; p.od_w_out = (const float*)d_in[13]; p.c_dw_w = (const float*)d_in[14]; p.c_dw_b = (const float*)d_in[15];
    p.c_ln_g = (const float*)d_in[16]; p.c_ln_b = (const float*)d_in[17]; p.d_rpb = (const float*)d_in[18]; p.final_g = (const float*)d_in[19];
    p.out = (float*)d_out;
    char* ws = (char*)d_ws; size_t off = 0;
    auto take = [&](size_t bytes) { char* r = ws + off; off += (bytes + 255) & ~(size_t)255; return r; };
    p.bar = (unsigned*)take(XCD_BAR_WORDS * 4);
    p.mvec = (float*)take((size_t)4 * 9 * 3072 * 4);
    p.rope = (float*)take((size_t)2048 * 64 * 4);
    p.wt_ev_in = (bf16_t*)take((size_t)2 * 2560 * 1024 * 2);
    p.wt_ev_out = (bf16_t*)take((size_t)2 * 1024 * 1024 * 2);
    p.wt_od_in = (bf16_t*)take((size_t)2 * 3584 * 1024 * 2);
    p.wt_od_out = (bf16_t*)take((size_t)2 * 1024 * 1024 * 2);
    p.xctx = (float*)take((size_t)NB * CTX * DM * 4);
    p.h = (bf16_t*)take((size_t)MROWS * 1024 * 2);
    p.qbuf = (bf16_t*)take((size_t)MROWS * 1024 * 2);
    p.gbuf = (bf16_t*)take((size_t)MROWS * 1024 * 2);
    p.cbuf = (bf16_t*)take((size_t)MROWS * 1536 * 2);
    p.kbuf = (bf16_t*)take((size_t)NB * 8 * TB * 64 * 2);
    p.vT = (bf16_t*)take((size_t)NB * 8 * 64 * TB * 2);
    if (off > ws_size) { fprintf(stderr, "workspace too small: need %zu have %zu\n", off, ws_size); return; }

    static int grid_blocks = 0;
    if (!grid_blocks) {
        int dev = 0, cus = 0, per_cu = 0;
        hipGetDevice(&dev);
        hipDeviceGetAttribute(&cus, hipDeviceAttributeMultiprocessorCount, dev);
        hipOccupancyMaxActiveBlocksPerMultiprocessor(&per_cu, fwd_kernel, 256, 0);
        if (per_cu > 2) per_cu = 2;
        if (per_cu < 1) per_cu = 1;
        grid_blocks = cus * per_cu;
        grid_blocks &= ~7;
    }
#if MULTI_LAUNCH
    for (int ph = 0; ph < 18; ++ph) hipLaunchKernelGGL(fwd_kernel, dim3(grid_blocks), dim3(256), 0, stream, p, ph, ph + 1);
#else
    hipMemsetAsync(p.bar, 0, XCD_BAR_WORDS * 4, stream);
    int ph0 = 0, ph1 = 18;
    void* args[] = {&p, &ph0, &ph1};
    hipError_t e = hipLaunchCooperativeKernel((void*)fwd_kernel, dim3(grid_blocks), dim3(256), args, 0, stream);
    if (e != hipSuccess) fprintf(stderr, "cooperative launch failed: %s (grid %d)\n", hipGetErrorString(e), grid_blocks);
#endif
}
```

```cpp
#include <hip/hip_runtime.h>
#include <hip/hip_cooperative_groups.h>
#include <cstdint>
#include <cstdio>

#ifndef MULTI_LAUNCH
#define MULTI_LAUNCH 0
#endif

#define DI __device__ __forceinline__
#define LAS __attribute__((address_space(3)))

typedef unsigned short bf16_t;
typedef short bf16x8 __attribute__((ext_vector_type(8)));
typedef float f32x16 __attribute__((ext_vector_type(16)));
typedef float f32x4 __attribute__((ext_vector_type(4)));
typedef float f32x2 __attribute__((ext_vector_type(2)));
typedef unsigned u32x4 __attribute__((ext_vector_type(4)));
typedef unsigned u32x2 __attribute__((ext_vector_type(2)));
typedef __bf16 bf16v2 __attribute__((ext_vector_type(2)));

constexpr int NB = 8, SEQ = 2048, DM = 1024, CTX = 256, TB = 2304, MROWS = NB * TB;
constexpr float EPS = 1e-6f, LOG2E = 1.4426950408889634f;
constexpr int LROW = 144;
constexpr int GT_BYTES = 128 * LROW;
constexpr int LDS_BYTES = 73728;

struct Params {
    const float *x, *c, *ctx, *c_ctx, *mod_w, *mod_b, *norm_g, *ev_w_in, *ev_w_out, *a_q_gain, *a_k_gain, *b_sink,
        *od_w_in, *od_w_out, *c_dw_w, *c_dw_b, *c_ln_g, *c_ln_b, *d_rpb, *final_g;
    float* out;
    unsigned* bar;
    float* mvec;
    float* rope;
    bf16_t *wt_ev_in, *wt_ev_out, *wt_od_in, *wt_od_out;
    float* xctx;
    bf16_t* h;
    bf16_t* qbuf;
    bf16_t* gbuf;
    bf16_t* cbuf;
    bf16_t* kbuf;
    bf16_t* vT;
};

DI unsigned pk2(float a, float b) { f32x2 v = {a, b}; bf16v2 r = __builtin_convertvector(v, bf16v2); return __builtin_bit_cast(unsigned, r); }
DI float bf_lo(unsigned u) { return __uint_as_float(u << 16); }
DI float bf_hi(unsigned u) { return __uint_as_float(u & 0xffff0000u); }
DI float silu_f(float x) { return x * __builtin_amdgcn_rcpf(1.f + __builtin_amdgcn_exp2f(-LOG2E * x)); }
DI float sigmoid_f(float x) { return __builtin_amdgcn_rcpf(1.f + __builtin_amdgcn_exp2f(-LOG2E * x)); }
DI int otid() { int t = threadIdx.x; asm volatile("" : "+v"(t)); return t; }
DI float max3f(float a, float b, float c) { float r; asm("v_max3_f32 %0, %1, %2, %3" : "=v"(r) : "v"(a), "v"(b), "v"(c)); return r; }
#define MFMA32(a, b, c) __builtin_amdgcn_mfma_f32_32x32x16_bf16((a), (b), (c), 0, 0, 0)

DI const float* res_in_row(const Params& p, int layer, int r) {
    const int b = r / TB, t = r - b * TB;
    if (t < CTX) return (layer == 0 ? p.ctx : (const float*)p.xctx) + (size_t)(b * CTX + t) * DM;
    return (layer == 0 ? p.x : (const float*)p.out) + (size_t)(b * SEQ + t - CTX) * DM;
}
DI float* res_out_row(const Params& p, int r) {
    const int b = r / TB, t = r - b * TB;
    if (t < CTX) return p.xctx + (size_t)(b * CTX + t) * DM;
    return p.out + (size_t)(b * SEQ + t - CTX) * DM;
}

#define XB_TMO      128
#define XB_XCNT(j)  (256  + 64 * (j))
#define XB_XSUB(j)  (1280 + 64 * (j))
#define XB_XGEN(j)  (2304 + 64 * (j))
#define XB_TOP      3328
#define XB_TOPGEN   3392
#define XB_LSUB(j)  (3456 + 64 * (j))
#define XB_LGEN(j)  (4480 + 64 * (j))
#define XCD_BAR_WORDS 5504
#define XB_SPIN_CAP (1u << 22)
DI unsigned xb_ld(unsigned* p) { return __hip_atomic_load(p, __ATOMIC_RELAXED, __HIP_MEMORY_SCOPE_AGENT); }
DI unsigned xb_add(unsigned* p, unsigned v) { return __hip_atomic_fetch_add(p, v, __ATOMIC_RELAXED, __HIP_MEMORY_SCOPE_AGENT); }
DI unsigned xb_xcc_id() { return (unsigned)__builtin_amdgcn_s_getreg((3 << 11) | 20) & 0xFu; }
#define XB_SPIN(cond, bar) do { unsigned _sp = 0; while (cond) { __builtin_amdgcn_s_sleep(1); \
    if ((++_sp & 255u) == 0u) { if (xb_ld(&(bar)[XB_TMO])) break; if (_sp > XB_SPIN_CAP) { atomicAdd(&(bar)[XB_TMO], 1u); break; } } } } while (0)
struct XcdBarrier { unsigned* bar; unsigned x; volatile LAS unsigned* st; };
DI XcdBarrier xcd_barrier_post(unsigned* bar, volatile LAS unsigned* st) {
    XcdBarrier b; b.bar = bar; b.x = xb_xcc_id(); b.st = st;
    if (threadIdx.x == 0) st[3] = xb_add(&bar[XB_XCNT(b.x)], 1u);
    return b;
}
DI void xcd_barrier_complete(unsigned* bar, unsigned x, unsigned& nloc, unsigned& nx, unsigned& xidx) {
    const unsigned G = gridDim.x * gridDim.y * gridDim.z;
    unsigned sum, cnt, mine, below, sp = 0u;
    for (;;) {
        sum = 0u; cnt = 0u; mine = 0u; below = 0u;
#pragma unroll
        for (unsigned j = 0; j < 16; ++j) { const unsigned c = xb_ld(&bar[XB_XCNT(j)]); sum += c; cnt += (c > 0u) ? 1u : 0u; mine = (j == x) ? c : mine; below += (c > 0u && j < x) ? 1u : 0u; }
        if (sum == G) break;
        __builtin_amdgcn_s_sleep(1);
        if ((++sp & 255u) == 0u) { if (xb_ld(&bar[XB_TMO])) break; if (sp > XB_SPIN_CAP) { atomicAdd(&bar[XB_TMO], 1u); break; } }
    }
    nloc = mine > 0u ? mine : 1u; nx = cnt > 0u ? cnt : 1u; xidx = below;
}
DI void xcd_barrier(const XcdBarrier& b) {
    asm volatile("s_waitcnt vmcnt(0)" ::: "memory");
    __syncthreads();
    if (threadIdx.x == 0) {
        unsigned* bar = b.bar;
        asm volatile("" : "+s"(bar));
        __builtin_amdgcn_s_waitcnt(0);
        unsigned nloc = b.st[0], nx = b.st[1];
        if (nloc == 0u) { unsigned xidx; xcd_barrier_complete(bar, b.x, nloc, nx, xidx); b.st[0] = nloc; b.st[1] = nx; b.st[2] = xidx; }
        const unsigned old = xb_add(&bar[XB_XSUB(b.x)], 1u);
        const unsigned gen = old / nloc;
        if (old + 1u == (gen + 1u) * nloc) {
            __builtin_amdgcn_fence(__ATOMIC_RELEASE, "agent");
            asm volatile("s_waitcnt vmcnt(0)" ::: "memory");
            const unsigned og = xb_add(&bar[XB_TOP], 1u);
            const unsigned tg = og / nx;
            if (og + 1u == (tg + 1u) * nx) xb_add(&bar[XB_TOPGEN], 1u);
            else XB_SPIN(xb_ld(&bar[XB_TOPGEN]) == tg, bar);
            __builtin_amdgcn_fence(__ATOMIC_ACQUIRE, "agent");
            xb_add(&bar[XB_XGEN(b.x)], 1u);
            asm volatile("s_waitcnt vmcnt(0)" ::: "memory");
        } else {
            XB_SPIN(xb_ld(&bar[XB_XGEN(b.x)]) == gen, bar);
            __builtin_amdgcn_fence(__ATOMIC_ACQUIRE, "agent");
            asm volatile("s_waitcnt vmcnt(0)" ::: "memory");
        }
    }
    __syncthreads();
}

DI void xcc_barrier(const XcdBarrier& b) {
    asm volatile("s_waitcnt vmcnt(0)" ::: "memory");
    __syncthreads();
    if (threadIdx.x == 0) {
        unsigned* bar = b.bar;
        asm volatile("" : "+s"(bar));
        __builtin_amdgcn_s_waitcnt(0);
        const unsigned nloc = b.st[0];
        const unsigned old = xb_add(&bar[XB_LSUB(b.x)], 1u);
        const unsigned gen = old / nloc;
        if (old + 1u == (gen + 1u) * nloc) xb_add(&bar[XB_LGEN(b.x)], 1u);
        else XB_SPIN(xb_ld(&bar[XB_LGEN(b.x)]) == gen, bar);
        __builtin_amdgcn_fence(__ATOMIC_ACQUIRE, "agent");
        asm volatile("s_waitcnt vmcnt(0)" ::: "memory");
    }
    __syncthreads();
}

struct Grp { int xcd, local, nlocal, nx; };

DI void mod_item(const Params& p, char* lds, int item) {
    const int tid = otid();
    const int layer = item / 48, n0 = (item % 48) * 64;
    float* sc = (float*)lds;
    float* part = (float*)(lds + 36864);
    __syncthreads();
    for (int i = tid; i < 9 * 1024; i += 256) { const int j = i >> 10, k = i & 1023; const float v = (j < 8) ? p.c[j * 1024 + k] : p.c_ctx[k]; sc[i] = silu_f(v); }
    __syncthreads();
    const int kg = tid >> 4, c4 = (tid & 15) * 4;
    f32x4 acc[9];
#pragma unroll
    for (int j = 0; j < 9; ++j) acc[j] = (f32x4){0.f, 0.f, 0.f, 0.f};
    const float* wp = p.mod_w + ((size_t)layer * 1024 + kg * 64) * 3072 + n0 + c4;
    const float* scp = sc + kg * 64;
#pragma unroll 16
    for (int k = 0; k < 64; ++k) {
        const f32x4 wv = *(const f32x4*)(wp + (size_t)k * 3072);
#pragma unroll
        for (int j = 0; j < 9; ++j) { const float sv = scp[j * 1024 + k]; acc[j] += wv * sv; }
    }
#pragma unroll
    for (int j = 0; j < 9; ++j) *(f32x4*)(part + (kg * 9 + j) * 64 + c4) = acc[j];
    __syncthreads();
    for (int i = tid; i < 9 * 64; i += 256) {
        const int j = i >> 6, cc = i & 63;
        float sm = p.mod_b[layer * 3072 + n0 + cc];
#pragma unroll
        for (int g = 0; g < 16; ++g) sm += part[(g * 9 + j) * 64 + cc];
        p.mvec[((size_t)layer * 9 + j) * 3072 + n0 + cc] = sm;
    }
}

DI void rope_item(const Params& p, int item) {
    const int idx = item * 256 + otid();
    const int t = idx >> 5, pp = idx & 31;
    const float pos = (float)((pp < 16) ? (t >> 6) : (t & 63));
    const float freq = powf(10000.0f, -(float)(pp & 15) / 16.0f);
    const float ang = pos * freq;
    float sn, cs; sincosf(ang, &sn, &cs);
    *(f32x2*)(p.rope + (size_t)idx * 2) = (f32x2){cs, sn};
}

DI void wconv_item(const float* __restrict__ W, bf16_t* __restrict__ Wt, int N, int tile, char* lds) {
    const int tid = otid();
    const int ntn = N >> 6, kt = tile / ntn, nt_ = tile - kt * ntn, k0 = kt * 64, n0 = nt_ * 64;
    float* tl = (float*)lds;
    __syncthreads();
#pragma unroll
    for (int j = 0; j < 4; ++j) {
        const int kk = (tid >> 4) + 16 * j, nn = (tid & 15) * 4;
        const f32x4 v = *(const f32x4*)(W + (size_t)(k0 + kk) * N + n0 + nn);
        tl[kk * 65 + nn + 0] = v[0]; tl[kk * 65 + nn + 1] = v[1]; tl[kk * 65 + nn + 2] = v[2]; tl[kk * 65 + nn + 3] = v[3];
    }
    __syncthreads();
#pragma unroll
    for (int j = 0; j < 2; ++j) {
        const int idx = tid + 256 * j, n = idx >> 3, kc = (idx & 7) * 8;
        u32x4 o;
        o[0] = pk2(tl[(kc + 0) * 65 + n], tl[(kc + 1) * 65 + n]);
        o[1] = pk2(tl[(kc + 2) * 65 + n], tl[(kc + 3) * 65 + n]);
        o[2] = pk2(tl[(kc + 4) * 65 + n], tl[(kc + 5) * 65 + n]);
        o[3] = pk2(tl[(kc + 6) * 65 + n], tl[(kc + 7) * 65 + n]);
        *(u32x4*)(Wt + (size_t)(n0 + n) * 1024 + k0 + kc) = o;
    }
}

DI void wconv_tile(const Params& p, char* lds, int t) {
    int w = t; const int j = w >> 11; w &= 2047;
    if (w < 640) wconv_item(p.ev_w_in + (size_t)j * 1024 * 2560, p.wt_ev_in + (size_t)j * 2560 * 1024, 2560, w, lds);
    else if (w < 896) wconv_item(p.ev_w_out + (size_t)j * 1024 * 1024, p.wt_ev_out + (size_t)j * 1024 * 1024, 1024, w - 640, lds);
    else if (w < 1792) wconv_item(p.od_w_in + (size_t)j * 1024 * 3584, p.wt_od_in + (size_t)j * 3584 * 1024, 3584, w - 896, lds);
    else wconv_item(p.od_w_out + (size_t)j * 1024 * 1024, p.wt_od_out + (size_t)j * 1024 * 1024, 1024, w - 1792, lds);
}
DI void phase0(const Params& p, char* lds) {
    const int G = gridDim.x, b = blockIdx.x;
    if (G >= 448) {
        if (b < 192) mod_item(p, lds, b);
        else if (b < 448) rope_item(p, b - 192);
        if (b < 192) { for (int k = 0; k < 4; ++k) wconv_tile(p, lds, b + 192 * k); }
        else { for (int t = 768 + (b - 192); t < 4096; t += G - 192) wconv_tile(p, lds, t); }
    } else {
        const int total = 192 + 256 + 4096;
        for (int item = b; item < total; item += G) {
            if (item < 192) mod_item(p, lds, item);
            else if (item < 448) rope_item(p, item - 192);
            else wconv_tile(p, lds, item - 448);
        }
    }
}

DI void norm_phase(const Params& p, int layer, const Grp& grp) {
    const int lane = otid() & 63, w = otid() >> 6;
    const float* g = p.norm_g + layer * 1024;
    const int local = grp.local, nlocal = grp.nlocal;
    for (int xcd = grp.xcd; xcd < NB; xcd += grp.nx)
#pragma unroll 1
        for (int seg = 0; seg < 2; ++seg) {
            const int cond = seg ? xcd : 8;
            const float* mv = p.mvec + ((size_t)layer * 9 + cond) * 3072;
            f32x4 mul[4], add[4];
#pragma unroll
            for (int j = 0; j < 4; ++j) {
                const int c0 = lane * 4 + 256 * j;
                const f32x4 gg = *(const f32x4*)(g + c0), sh = *(const f32x4*)(mv + c0), sc = *(const f32x4*)(mv + 1024 + c0);
#pragma unroll
                for (int e = 0; e < 4; ++e) { mul[j][e] = gg[e] * (1.f + sc[e]); add[j][e] = sh[e]; }
            }
            const int i0 = seg ? CTX / 4 : 0, i1 = seg ? TB / 4 : CTX / 4;
            for (int li = i0 + local; li < i1; li += nlocal) {
                const int r = (xcd * (TB / 4) + li) * 4 + w;
                const float* xr = res_in_row(p, layer, r);
                f32x4 v[4]; float ss = 0.f;
#pragma unroll
                for (int j = 0; j < 4; ++j) { v[j] = *(const f32x4*)(xr + lane * 4 + 256 * j); ss += v[j][0] * v[j][0] + v[j][1] * v[j][1] + v[j][2] * v[j][2] + v[j][3] * v[j][3]; }
#pragma unroll
                for (int o = 32; o >= 1; o >>= 1) ss += __shfl_xor(ss, o);
                const float rstd = rsqrtf(ss * (1.0f / 1024.0f) + EPS);
                bf16_t* hr = p.h + (size_t)r * 1024;
#pragma unroll
                for (int j = 0; j < 4; ++j) {
                    const int c0 = lane * 4 + 256 * j;
                    float y[4];
#pragma unroll
                    for (int e = 0; e < 4; ++e) y[e] = (v[j][e] * rstd) * mul[j][e] + add[j][e];
                    *(u32x2*)(hr + c0) = (u32x2){pk2(y[0], y[1]), pk2(y[2], y[3])};
                }
            }
        }
}

DI void final_phase(const Params& p, const Grp& g) {
    const int lane = otid() & 63, w = otid() >> 6;
    const int local = g.local, nlocal = g.nlocal;
    f32x4 fg[4];
#pragma unroll
    for (int j = 0; j < 4; ++j) fg[j] = *(const f32x4*)(p.final_g + lane * 4 + 256 * j);
    for (int xcd = g.xcd; xcd < NB; xcd += g.nx)
    for (int li = local; li < SEQ / 4; li += nlocal) {
        const int item = xcd * (SEQ / 4) + li;
        const int r = item * 4 + w;
        float* xr = p.out + (size_t)r * 1024;
        f32x4 v[4]; float ss = 0.f;
#pragma unroll
        for (int j = 0; j < 4; ++j) { v[j] = *(const f32x4*)(xr + lane * 4 + 256 * j); ss += v[j][0] * v[j][0] + v[j][1] * v[j][1] + v[j][2] * v[j][2] + v[j][3] * v[j][3]; }
#pragma unroll
        for (int o = 32; o >= 1; o >>= 1) ss += __shfl_xor(ss, o);
        const float rstd = rsqrtf(ss * (1.0f / 1024.0f) + EPS);
#pragma unroll
        for (int j = 0; j < 4; ++j) {
            const int c0 = lane * 4 + 256 * j;
            f32x4 o;
#pragma unroll
            for (int e = 0; e < 4; ++e) o[e] = v[j][e] * rstd * fg[j][e];
            *(f32x4*)(xr + c0) = o;
        }
    }
}

DI void dma16(const void* gsrc, unsigned lds_dst) { unsigned keep;
    asm volatile("s_mov_b32 %0, m0\n\ts_mov_b32 m0, %2\n\ts_nop 0\n\tglobal_load_lds_dwordx4 %1, off\n\ts_mov_b32 m0, %0" : "=&s"(keep) : "v"(gsrc), "s"(lds_dst) : "memory"); }
DI void dma16s(const void* base, unsigned voff, unsigned lds_dst) { unsigned keep;
    asm volatile("s_mov_b32 %0, m0\n\ts_mov_b32 m0, %3\n\ts_nop 0\n\tglobal_load_lds_dwordx4 %1, %2\n\ts_mov_b32 m0, %0" : "=&s"(keep) : "v"(voff), "s"(base), "s"(lds_dst) : "memory"); }
#define WAIT_BAR(N) asm volatile("s_waitcnt vmcnt(" #N ") lgkmcnt(0)\n\ts_barrier" ::: "memory")
#define WAIT_VM(n) asm volatile("s_waitcnt vmcnt(" #n ")" ::: "memory")

template <bool SWAP, int TI, int GP = 0>
DI void gemm_mainloop(const bf16_t* __restrict__ A, const bf16_t* __restrict__ W, int row0, int col0, f32x16 (&acc)[2 * TI], char* lds, bool pre_issued) {
    constexpr int MT = 64 * TI, STAGE = (MT + 128) * 64, NST = (TI == 4) ? 3 : 4, NA = TI, KT = 32;
    const int tid = otid(), lane = tid & 63, w = __builtin_amdgcn_readfirstlane(tid >> 6), wm = w >> 1, wn = w & 1, l31 = lane & 31, hh = lane >> 5;
    const int cc = (lane & 3) ^ ((lane >> 4) & 3);
    const unsigned pa = (unsigned)(((row0 + 16 * w + (lane >> 2)) * 1024 + cc * 8) * 2);
    const unsigned pb = (unsigned)(((col0 + 16 * w + (lane >> 2)) * 1024 + cc * 8) * 2);
    const unsigned l3 = (unsigned)(size_t)lds + w * 1024;
    const int sw = (l31 >> 2) & 3;
    const char* fa = lds + (wm * (32 * TI) + l31) * 64;
    const char* fb = lds + MT * 64 + (wn * 64 + l31) * 64;
    const int ch0 = ((0 + hh) ^ sw) * 16, ch1 = ((2 + hh) ^ sw) * 16;
#pragma unroll
    for (int i = 0; i < 2 * TI; ++i)
#pragma unroll
        for (int e = 0; e < 16; ++e) acc[i][e] = 0.f;
    if (!pre_issued) WAIT_BAR(0);
#define GEMM_ISSUE(kt, st) do { const unsigned _sb = l3 + (st) * STAGE; const int _ko = (kt) * 32; \
        _Pragma("unroll") for (int _j = 0; _j < NA; ++_j) dma16s(A, pa + (_j * 64 * 1024 + _ko) * 2, _sb + _j * 4096); \
        _Pragma("unroll") for (int _j = 0; _j < 2; ++_j) dma16s(W, pb + (_j * 64 * 1024 + _ko) * 2, _sb + MT * 64 + _j * 4096); } while (0)
#define GEMM_STAGE(DO_ISSUE, ktn) do { \
        const char* sa = fa + rs * STAGE; const char* sb = fb + rs * STAGE; \
        const unsigned _sbase = l3 + is * STAGE; const int _ko = (ktn) * 32; \
        bf16x8 af[2][TI], bf[2][2]; \
        _Pragma("unroll") for (int ks = 0; ks < 2; ++ks) { const int ch = ks ? ch1 : ch0; \
            _Pragma("unroll") for (int i = 0; i < TI; ++i) af[ks][i] = *(const bf16x8*)(sa + i * 32 * 64 + ch); \
            _Pragma("unroll") for (int j = 0; j < 2; ++j) bf[ks][j] = *(const bf16x8*)(sb + j * 32 * 64 + ch); } \
        _Pragma("unroll") for (int m = 0; m < 4 * TI; ++m) { \
            const int ks = m / (2 * TI), i = (m % (2 * TI)) >> 1, j = m & 1; \
            if (SWAP) acc[i * 2 + j] = MFMA32(af[ks][i], bf[ks][j], acc[i * 2 + j]); \
            else      acc[j * TI + i] = MFMA32(bf[ks][j], af[ks][i], acc[j * TI + i]); \
            if (DO_ISSUE && (m & 1) && (m >> 1) < NA + 2) { const int q = m >> 1; \
                __builtin_amdgcn_sched_barrier(0); \
                if (q < NA) dma16s(A, pa + (q * 64 * 1024 + _ko) * 2, _sbase + q * 4096); \
                else dma16s(W, pb + ((q - NA) * 64 * 1024 + _ko) * 2, _sbase + MT * 64 + (q - NA) * 4096); \
                __builtin_amdgcn_sched_barrier(0); } } \
        rs = (rs + 1 == NST) ? 0 : rs + 1; } while (0)
    if (TI == 2) {
        if (!pre_issued) { GEMM_ISSUE(0, 0); GEMM_ISSUE(1, 1); }
        int rs = 0, is = 2;
#pragma unroll 1
        for (int kp = 0; kp < KT / 2 - 1; ++kp) {
            WAIT_BAR(0);
            GEMM_STAGE(true, 2 * kp + 2);
            is = (is + 1) & 3;
            GEMM_STAGE(true, 2 * kp + 3);
            is = (is + 1) & 3;
        }
        WAIT_BAR(0);
        GEMM_STAGE(false, 0);
        GEMM_STAGE(false, 0);
    } else {
    if (!pre_issued) {
#pragma unroll
        for (int s = 0; s < NST - 1; ++s) GEMM_ISSUE(s, s);
    }
    int rs = 0, is = NST - 1;
#pragma unroll 1
    for (int kt = 0; kt < KT - (NST - 1); ++kt) {
        if (TI == 4) WAIT_BAR(6); else WAIT_BAR(8);
        GEMM_STAGE(true, kt + NST - 1);
        is = (is + 1 == NST) ? 0 : is + 1;
    }
#pragma unroll 1
    for (int kt = KT - (NST - 1); kt < KT; ++kt) {
        WAIT_BAR(0);
        GEMM_STAGE(false, 0);
    }
    }
#undef GEMM_STAGE
#undef GEMM_ISSUE
}

template <int TI>
DI void gemm_prefetch(const bf16_t* __restrict__ A, const bf16_t* __restrict__ W, int row0, int col0, char* lds) {
    constexpr int MT = 64 * TI, STAGE = (MT + 128) * 64, NST = (TI == 4) ? 3 : 4, NA = TI;
    const int tid = otid(), lane = tid & 63, w = __builtin_amdgcn_readfirstlane(tid >> 6);
    const int cc = (lane & 3) ^ ((lane >> 4) & 3);
    const unsigned pa = (unsigned)(((row0 + 16 * w + (lane >> 2)) * 1024 + cc * 8) * 2);
    const unsigned pb = (unsigned)(((col0 + 16 * w + (lane >> 2)) * 1024 + cc * 8) * 2);
    const unsigned l3 = (unsigned)(size_t)lds + w * 1024;
    asm volatile("s_waitcnt lgkmcnt(0)\n\ts_barrier" ::: "memory");
#pragma unroll
    for (int s = 0; s < ((TI == 2) ? 2 : NST - 1); ++s) {
        const unsigned sb = l3 + s * STAGE; const int ko = s * 32;
#pragma unroll
        for (int j = 0; j < NA; ++j) dma16s(A, pa + (j * 64 * 1024 + ko) * 2, sb + j * 4096);
#pragma unroll
        for (int j = 0; j < 2; ++j) dma16s(W, pb + (j * 64 * 1024 + ko) * 2, sb + MT * 64 + j * 4096);
    }
}

DI void store_pair16(bf16_t* pairp  , int hh, unsigned a0, unsigned a1, unsigned b0, unsigned b1) {
    const u32x2 r0 = __builtin_amdgcn_permlane32_swap(a0, b0, false, false);
    const u32x2 r1 = __builtin_amdgcn_permlane32_swap(a1, b1, false, false);
    *(u32x4*)(pairp + 8 * hh) = (u32x4){r0[0], r1[0], r0[1], r1[1]};
}

template <int TR, int TI>
DI void epi_plain(const f32x16 (&acc)[2 * TI], bf16_t* dst, int stride, int row0) {
    const int lane = otid() & 63, w = __builtin_amdgcn_readfirstlane(otid() >> 6), wm = w >> 1, l31 = lane & 31, hh = lane >> 5;
#pragma unroll
    for (int ti = 0; ti < TI; ++ti) {
        const int r = row0 + wm * (32 * TI) + 32 * ti + l31;
        bf16_t* rp = dst + (size_t)r * stride;
#pragma unroll
        for (int fi = 0; fi < 2; ++fi)
#pragma unroll
            for (int gp = 0; gp < 2; ++gp) {
                float v[8];
#pragma unroll
                for (int e = 0; e < 8; ++e) { float x = acc[fi * TI + ti][8 * gp + e]; if (TR == 1) x = silu_f(x); if (TR == 2) x *= 0.125f; v[e] = x; }
                store_pair16(rp + 32 * fi + 16 * gp, hh, pk2(v[0], v[1]), pk2(v[2], v[3]), pk2(v[4], v[5]), pk2(v[6], v[7]));
            }
    }
}

template <bool RMS, bool ISQ, int TI>
DI void epi_qk(const Params& p, const f32x16 (&acc)[2 * TI], const float* gain, int row0, bf16_t* qdst  , int kslot, int nkv) {
    const int lane = otid() & 63, w = __builtin_amdgcn_readfirstlane(otid() >> 6), wm = w >> 1, l31 = lane & 31, hh = lane >> 5;
#pragma unroll
    for (int ti = 0; ti < TI; ++ti) {
        const int r = row0 + wm * (32 * TI) + 32 * ti + l31;
        const int b = r / TB, t = r - b * TB;
        float v[2][16];
#pragma unroll
        for (int fi = 0; fi < 2; ++fi)
#pragma unroll
            for (int e = 0; e < 16; ++e) v[fi][e] = acc[fi * TI + ti][e];
        if (RMS) {
            float ss = 0.f;
#pragma unroll
            for (int fi = 0; fi < 2; ++fi)
#pragma unroll
                for (int e = 0; e < 16; ++e) ss += v[fi][e] * v[fi][e];
            ss += __shfl_xor(ss, 32);
            const float rstd = rsqrtf(ss * (1.0f / 64.0f) + EPS);
#pragma unroll
            for (int fi = 0; fi < 2; ++fi)
#pragma unroll
                for (int g = 0; g < 4; ++g) {
                    const f32x4 gg = *(const f32x4*)(gain + 32 * fi + 8 * g + 4 * hh);
#pragma unroll
                    for (int e = 0; e < 4; ++e) v[fi][4 * g + e] = v[fi][4 * g + e] * rstd * gg[e];
                }
        }
        if (t >= CTX) {
            const float* rt = p.rope + (size_t)(t - CTX) * 64;
#pragma unroll
            for (int fi = 0; fi < 2; ++fi)
#pragma unroll
                for (int g = 0; g < 4; ++g) {
                    const f32x4 cs = *(const f32x4*)(rt + (16 * fi + 4 * g + 2 * hh) * 2);
                    const float x0 = v[fi][4 * g + 0], x1 = v[fi][4 * g + 1], x2 = v[fi][4 * g + 2], x3 = v[fi][4 * g + 3];
                    v[fi][4 * g + 0] = x0 * cs[0] - x1 * cs[1];
                    v[fi][4 * g + 1] = x0 * cs[1] + x1 * cs[0];
                    v[fi][4 * g + 2] = x2 * cs[2] - x3 * cs[3];
                    v[fi][4 * g + 3] = x2 * cs[3] + x3 * cs[2];
                }
        }
        bf16_t* rp = ISQ ? (qdst + (size_t)r * 1024) : (p.kbuf + ((size_t)(b * nkv + kslot) * TB + t) * 64);
#pragma unroll
        for (int fi = 0; fi < 2; ++fi)
#pragma unroll
            for (int gp = 0; gp < 2; ++gp) {
                float o[8];
#pragma unroll
                for (int e = 0; e < 8; ++e) o[e] = ISQ ? v[fi][8 * gp + e] * 0.125f : v[fi][8 * gp + e];
                store_pair16(rp + 32 * fi + 16 * gp, hh, pk2(o[0], o[1]), pk2(o[2], o[3]), pk2(o[4], o[5]), pk2(o[6], o[7]));
            }
    }
}

template <int TI>
DI void epi_k_plain(const Params& p, const f32x16 (&acc)[2 * TI], int row0, int kslot, int nkv) {
    const int lane = otid() & 63, w = __builtin_amdgcn_readfirstlane(otid() >> 6), wm = w >> 1, l31 = lane & 31, hh = lane >> 5;
#pragma unroll
    for (int ti = 0; ti < TI; ++ti) {
        const int r = row0 + wm * (32 * TI) + 32 * ti + l31;
        const int b = r / TB, t = r - b * TB;
        bf16_t* rp = p.kbuf + ((size_t)(b * nkv + kslot) * TB + t) * 64;
#pragma unroll
        for (int fi = 0; fi < 2; ++fi)
#pragma unroll
            for (int gp = 0; gp < 2; ++gp)
                store_pair16(rp + 32 * fi + 16 * gp, hh, pk2(acc[fi * TI + ti][8 * gp], acc[fi * TI + ti][8 * gp + 1]), pk2(acc[fi * TI + ti][8 * gp + 2], acc[fi * TI + ti][8 * gp + 3]),
                             pk2(acc[fi * TI + ti][8 * gp + 4], acc[fi * TI + ti][8 * gp + 5]), pk2(acc[fi * TI + ti][8 * gp + 6], acc[fi * TI + ti][8 * gp + 7]));
    }
}

template <int TI>
DI void epi_v(const Params& p, const f32x16 (&acc)[2 * TI], int row0, int vslot, int nkv) {
    const int lane = otid() & 63, w = __builtin_amdgcn_readfirstlane(otid() >> 6), wm = w >> 1, l31 = lane & 31, hh = lane >> 5;
#pragma unroll
    for (int ti = 0; ti < TI; ++ti) {
        const int rb = row0 + wm * (32 * TI) + 32 * ti;
        const int b = rb / TB, tb = rb - b * TB;
#pragma unroll
        for (int fi = 0; fi < 2; ++fi) {
            const int d = 32 * fi + l31;
            bf16_t* vp = p.vT + ((size_t)(b * nkv + vslot) * 64 + d) * TB + tb;
#pragma unroll
            for (int gq = 0; gq < 2; ++gq) {
                u32x4 o;
                o[0] = pk2(acc[ti * 2 + fi][8 * gq + 0], acc[ti * 2 + fi][8 * gq + 1]);
                o[1] = pk2(acc[ti * 2 + fi][8 * gq + 2], acc[ti * 2 + fi][8 * gq + 3]);
                o[2] = pk2(acc[ti * 2 + fi][8 * gq + 4], acc[ti * 2 + fi][8 * gq + 5]);
                o[3] = pk2(acc[ti * 2 + fi][8 * gq + 6], acc[ti * 2 + fi][8 * gq + 7]);
                *(u32x4*)(vp + 16 * gq + 8 * hh) = o;
            }
        }
    }
}

#ifndef GPROBE
#define GPROBE 0
#endif
constexpr int TIN = 4;
DI void gemm_in_phase(const Params& p, int layer, char* lds, const Grp& g, bool do_epi = true) {
    const bool even = (layer & 1) == 0;
    const int j = layer >> 1;
    const int N = even ? 2560 : 3584, nct = N / 128;
    const bf16_t* W = even ? p.wt_ev_in + (size_t)j * 2560 * 1024 : p.wt_od_in + (size_t)j * 3584 * 1024;
    const bool last = (layer == 3);
    const int local = g.local, nlocal = g.nlocal;
    const int wn = __builtin_amdgcn_readfirstlane(otid() >> 6) & 1;
    constexpr int RT_PER_XCD = MROWS / (64 * TIN) / 8;
    const int nli = RT_PER_XCD * nct;
#define GIN_SKIP(li_) (last && ((li_) / nct == 0) && ((((li_) % nct) * 128 < 2048) || (((li_) % nct) * 128 >= 3072)))
    for (int xcd = g.xcd; xcd < NB; xcd += g.nx) {
    int li = local;
    while (li < nli && GIN_SKIP(li)) li += nlocal;
    bool pre = false;
    while (li < nli) {
        const int rtl = li / nct, ct = li - rtl * nct;
        const int rt = xcd * RT_PER_XCD + rtl;
        const int row0 = rt * (64 * TIN), col0 = ct * 128;
        const int c64 = col0 + wn * 64;
        const bool swap = even ? (col0 == 640 || col0 == 1920) : (col0 >= 2560 && col0 < 3072);
        f32x16 acc[2 * TIN];
        if (!do_epi) {
            gemm_mainloop<false, TIN, GPROBE>(p.h, W, row0, col0, acc, lds, false);
            float sm = 0.f;
#pragma unroll
            for (int i = 0; i < 2 * TIN; ++i)
#pragma unroll
                for (int e = 0; e < 16; ++e) sm += acc[i][e];
            if (sm == 12345.678f) p.mvec[0] = sm;
            li += nlocal;
            continue;
        }
        if (swap) gemm_mainloop<true, TIN>(p.h, W, row0, col0, acc, lds, pre);
        else gemm_mainloop<false, TIN>(p.h, W, row0, col0, acc, lds, pre);
        int ln = li + nlocal;
        while (ln < nli && GIN_SKIP(ln)) ln += nlocal;
        pre = ln < nli;
        if (pre) { const int rtl2 = ln / nct, ct2 = ln - rtl2 * nct; gemm_prefetch<TIN>(p.h, W, (xcd * RT_PER_XCD + rtl2) * (64 * TIN), ct2 * 128, lds); }
        li = ln;
        if (even) {
            if (swap) epi_v<TIN>(p, acc, row0, (col0 == 640 ? 0 : 2) + wn, 4);
            else if (col0 < 512) epi_qk<true, true, TIN>(p, acc, p.a_q_gain + j * 64, row0, p.qbuf + c64, 0, 4);
            else if (col0 < 640) epi_qk<true, false, TIN>(p, acc, p.a_k_gain + j * 64, row0, nullptr, wn, 4);
            else if (col0 < 1280) epi_plain<1, TIN>(acc, p.gbuf + (c64 - 768), 1024, row0);
            else if (col0 < 1792) epi_qk<false, true, TIN>(p, acc, nullptr, row0, p.qbuf + 512 + (c64 - 1280), 0, 4);
            else if (col0 < 1920) epi_qk<false, false, TIN>(p, acc, nullptr, row0, nullptr, 2 + wn, 4);
            else epi_plain<1, TIN>(acc, p.gbuf + 512 + (c64 - 2048), 1024, row0);
        } else {
            if (swap) epi_v<TIN>(p, acc, row0, (c64 - 2560) >> 6, 8);
            else if (col0 < 1024) epi_plain<0, TIN>(acc, p.cbuf + c64, 1536, row0);
            else if (col0 < 1536) epi_plain<1, TIN>(acc, p.cbuf + c64, 1536, row0);
            else if (col0 < 2048) epi_plain<2, TIN>(acc, p.qbuf + (c64 - 1536), 512, row0);
            else if (col0 < 2560) epi_k_plain<TIN>(p, acc, row0, (c64 - 2048) >> 6, 8);
            else epi_plain<1, TIN>(acc, p.gbuf + (c64 - 3072), 512, row0);
        }
    }
    }
#undef GIN_SKIP
}

constexpr int TOUT = 2;
DI void gemm_out_phase(const Params& p, int layer, char* lds, const Grp& g) {
    const bool even = (layer & 1) == 0;
    const int j = layer >> 1;
    const bf16_t* W = (even ? p.wt_ev_out : p.wt_od_out) + (size_t)j * 1024 * 1024;
    const bool last = (layer == 3);
    const int local = g.local, nlocal = g.nlocal;
    constexpr int RT_PER_XCD = MROWS / (64 * TOUT) / 8;
    const int nli = RT_PER_XCD * 8;
#define GOUT_SKIP(li_) (last && ((li_) >> 3) < 2)
    for (int xcd = g.xcd; xcd < NB; xcd += g.nx) {
    int li = local;
    while (li < nli && GOUT_SKIP(li)) li += nlocal;
    bool pre = false;
    while (li < nli) {
        const int rtl = li >> 3, ct = li & 7;
        const int rt = xcd * RT_PER_XCD + rtl;
        const int row0 = rt * (64 * TOUT), col0 = ct * 128;
        f32x16 acc[2 * TOUT];
        gemm_mainloop<false, TOUT>(p.h  , W, row0, col0, acc, lds, pre);
        int ln = li + nlocal;
        while (ln < nli && GOUT_SKIP(ln)) ln += nlocal;
        pre = ln < nli;
        if (pre) gemm_prefetch<TOUT>(p.h, W, (xcd * RT_PER_XCD + (ln >> 3)) * (64 * TOUT), (ln & 7) * 128, lds);
        li = ln;
        const int lane = otid() & 63, w = __builtin_amdgcn_readfirstlane(otid() >> 6), wm = w >> 1, wn = w & 1, l31 = lane & 31, hh = lane >> 5;
#pragma unroll
        for (int ti = 0; ti < TOUT; ++ti) {
            const int r = row0 + wm * (32 * TOUT) + 32 * ti + l31;
            const int b = r / TB, t = r - b * TB;
            const int cond = (t < CTX) ? 8 : b;
            const float* gm = p.mvec + ((size_t)layer * 9 + cond) * 3072 + 2048;
            const float* xi = res_in_row(p, layer, r);
            float* xo = res_out_row(p, r);
#pragma unroll
            for (int fi = 0; fi < 2; ++fi)
#pragma unroll
                for (int g = 0; g < 4; ++g) {
                    const int c = col0 + wn * 64 + 32 * fi + 8 * g + 4 * hh;
                    const f32x4 xv = *(const f32x4*)(xi + c), gv = *(const f32x4*)(gm + c);
                    f32x4 o;
#pragma unroll
                    for (int e = 0; e < 4; ++e) o[e] = xv[e] + gv[e] * acc[fi * TOUT + ti][4 * g + e];
                    *(f32x4*)(xo + c) = o;
                }
        }
    }
    }
#undef GOUT_SKIP
}

template <int MODE>
DI void attn_block(char* lds, const bf16_t* __restrict__ Kb, const bf16_t* __restrict__ Vb, int nt, int lat_lo,
                   const bf16_t* __restrict__ qptr, int qstride, const bf16_t* __restrict__ gptr, int gstride, bf16_t* __restrict__ optr,
                   float sink_l2, int tq_base, const float* rpb_lds, int rq) {
    constexpr int ASTAGE = 16384, ANST = 3;
    const int tid = otid(), lane = tid & 63, w = __builtin_amdgcn_readfirstlane(tid >> 6), l31 = lane & 31, hh = lane >> 5;
    const int r8 = lane >> 3;
    const int cc = (lane & 7) ^ (4 * (w & 1) + (r8 >> 1));
    const unsigned kp = (unsigned)(((8 * w + r8) * 64 + cc * 8) * 2);
    const unsigned vp = (unsigned)(((8 * w + r8) * TB + cc * 8) * 2);
    const unsigned l3 = (unsigned)(size_t)lds + w * 1024;
#define ATT_ISSUE(itile, st) do { const int _t0 = ((itile) < 4) ? (itile) * 64 : CTX + lat_lo + ((itile) - 4) * 64; const unsigned _sb = l3 + (st) * ASTAGE; \
        dma16s(Kb, kp + _t0 * 128, _sb); dma16s(Kb, kp + (_t0 + 32) * 128, _sb + 4096); \
        dma16s(Vb, vp + _t0 * 2, _sb + 8192); dma16s(Vb, vp + (32 * TB + _t0) * 2, _sb + 8192 + 4096); } while (0)
    WAIT_BAR(0);
    ATT_ISSUE(0, 0);
    ATT_ISSUE(1, 1);
    bf16x8 qf[4];
#pragma unroll
    for (int ks = 0; ks < 4; ++ks) qf[ks] = *(const bf16x8*)(qptr + (size_t)l31 * qstride + 16 * ks + 8 * hh);
    asm volatile("" :: "v"(qf[0]), "v"(qf[1]), "v"(qf[2]), "v"(qf[3]));
    f32x16 O0, O1;
#pragma unroll
    for (int e = 0; e < 16; ++e) { O0[e] = 0.f; O1[e] = 0.f; }
    float mrun = (MODE == 1) ? sink_l2 : -1e30f;
    f32x16 Lacc;
#pragma unroll
    for (int e = 0; e < 16; ++e) Lacc[e] = (MODE == 1) ? 1.f : 0.f;
    const bf16x8 ones = __builtin_bit_cast(bf16x8, (u32x4){0x3F803F80u, 0x3F803F80u, 0x3F803F80u, 0x3F803F80u});
    const int tq = tq_base + l31;
    int cq = 0, cs_ = 0, rs = 0;
    if (MODE == 2) { cq = tq & 63; cs_ = min(max(cq - 8, 0), 48); rs = min(max(rq - 4, 0), 24); }
    const int swz = (l31 >> 1) & 7;
    const char* kbase = lds + l31 * 128;
    const char* vbase = lds + 8192 + l31 * 128;
    int rst = 0, ist = 2;
    if (MODE == 0) {
#define T15_QK(N0, N1, SLOT) do { const char* _k = kbase + (SLOT) * ASTAGE; \
            _Pragma("unroll") for (int e = 0; e < 16; ++e) { N0[e] = 0.f; N1[e] = 0.f; } \
            _Pragma("unroll") for (int ks = 0; ks < 4; ++ks) { const int ch = ((2 * ks + hh) ^ swz) * 16; \
                const bf16x8 k0 = *(const bf16x8*)(_k + ch), k1 = *(const bf16x8*)(_k + 32 * 128 + ch); \
                N0 = MFMA32(k0, qf[ks], N0); N1 = MFMA32(k1, qf[ks], N1); } } while (0)
#define T15_STEP(C0, C1, N0, N1, IT) do { \
            WAIT_BAR(0);                                     \
            if ((IT) + 2 < nt) { ATT_ISSUE((IT) + 2, ist); ist = (ist == 2) ? 0 : ist + 1; } \
            const char* ldsV = vbase + rst * ASTAGE; \
            rst = (rst == 2) ? 0 : rst + 1; \
            float mx = max3f(C0[0], C1[0], C0[1]); \
            _Pragma("unroll") for (int e = 1; e < 15; ++e) mx = max3f(mx, C1[e], C0[e + 1]); \
            mx = max3f(mx, C1[15], C1[15]) * LOG2E; \
            if (__any(mx > mrun + 8.0f)) { \
                const float mnew = max3f(mrun, mx, __shfl_xor(mx, 32)); \
                const float alpha = __builtin_amdgcn_exp2f(mrun - mnew); \
                _Pragma("unroll") for (int e = 0; e < 16; ++e) { O0[e] *= alpha; O1[e] *= alpha; Lacc[e] *= alpha; } \
                mrun = mnew; } \
            if ((IT) + 1 < nt) T15_QK(N0, N1, rst);          \
            _Pragma("unroll") for (int e = 0; e < 16; ++e) { \
                C0[e] = __builtin_amdgcn_exp2f(__builtin_fmaf(C0[e], LOG2E, -mrun)); \
                C1[e] = __builtin_amdgcn_exp2f(__builtin_fmaf(C1[e], LOG2E, -mrun)); } \
            if ((IT) + 1 < nt) { __builtin_amdgcn_sched_group_barrier(0x100, 8, 0); \
                _Pragma("unroll") for (int _g = 0; _g < 8; ++_g) { __builtin_amdgcn_sched_group_barrier(0x008, 1, 0); __builtin_amdgcn_sched_group_barrier(0x002, 8, 0); } } \
            _Pragma("unroll") for (int sub = 0; sub < 2; ++sub) \
            _Pragma("unroll") for (int sx = 0; sx < 2; ++sx) { \
                u32x4 pa; \
                if (sub == 0) { pa[0] = pk2(C0[8 * sx + 0], C0[8 * sx + 1]); pa[1] = pk2(C0[8 * sx + 2], C0[8 * sx + 3]); pa[2] = pk2(C0[8 * sx + 4], C0[8 * sx + 5]); pa[3] = pk2(C0[8 * sx + 6], C0[8 * sx + 7]); } \
                else          { pa[0] = pk2(C1[8 * sx + 0], C1[8 * sx + 1]); pa[1] = pk2(C1[8 * sx + 2], C1[8 * sx + 3]); pa[2] = pk2(C1[8 * sx + 4], C1[8 * sx + 5]); pa[3] = pk2(C1[8 * sx + 6], C1[8 * sx + 7]); } \
                const bf16x8 pfr = __builtin_bit_cast(bf16x8, pa); \
                const int ch = ((2 * (2 * sub + sx) + hh) ^ swz) * 16; \
                const bf16x8 v0 = *(const bf16x8*)(ldsV + ch), v1 = *(const bf16x8*)(ldsV + 32 * 128 + ch); \
                O0 = MFMA32(v0, pfr, O0); O1 = MFMA32(v1, pfr, O1); Lacc = MFMA32(ones, pfr, Lacc); } } while (0)
        f32x16 a0, a1, b0, b1;
        WAIT_BAR(4);
        T15_QK(a0, a1, 0);
#pragma unroll 1
        for (int it = 0; it < nt; it += 2) {
            T15_STEP(a0, a1, b0, b1, it);
            T15_STEP(b0, b1, a0, a1, it + 1);
        }
#undef T15_STEP
#undef T15_QK
    } else
#pragma unroll 1
    for (int it = 0; it < nt; ++it) {
        if (it + 1 < nt) WAIT_BAR(4); else WAIT_BAR(0);
        if (it + 2 < nt) { ATT_ISSUE(it + 2, ist); ist = (ist == 2) ? 0 : ist + 1; }
        const char* ldsK = kbase + rst * ASTAGE;
        const char* ldsV = vbase + rst * ASTAGE;
        rst = (rst == 2) ? 0 : rst + 1;
        bool active = true;
        int krow = 0;
        if (MODE == 2 && it >= 4) { krow = (lat_lo >> 6) + it - 4; active = (krow >= rs) && (krow < rs + 8); }
        if (active) {
            f32x16 s0, s1;
#pragma unroll
            for (int e = 0; e < 16; ++e) { s0[e] = 0.f; s1[e] = 0.f; }
            bf16x8 kf[2][4];
#pragma unroll
            for (int ks = 0; ks < 4; ++ks) {
                const int ch = ((2 * ks + hh) ^ swz) * 16;
                kf[0][ks] = *(const bf16x8*)(ldsK + ch);
                kf[1][ks] = *(const bf16x8*)(ldsK + 32 * 128 + ch);
            }
#pragma unroll
            for (int ks = 0; ks < 4; ++ks) {
                s0 = MFMA32(kf[0][ks], qf[ks], s0);
                s1 = MFMA32(kf[1][ks], qf[ks], s1);
            }
            bf16x8 vf[2][4];
#pragma unroll
            for (int q = 0; q < 4; ++q) {
                const int ch = ((2 * q + hh) ^ swz) * 16;
                vf[0][q] = *(const bf16x8*)(ldsV + ch);
                vf[1][q] = *(const bf16x8*)(ldsV + 32 * 128 + ch);
            }
            if (MODE != 2) {
                __builtin_amdgcn_sched_group_barrier(0x100, 8, 0);
                __builtin_amdgcn_sched_group_barrier(0x008, 8, 0);
                __builtin_amdgcn_sched_group_barrier(0x100, 8, 0);
            }
            const int kb_ = lat_lo + (it - 4) * 64;
            if (MODE == 1 && it >= 4 && !(kb_ >= tq_base - 97 && kb_ <= tq_base + 65)) {
                const int base = lat_lo + (it - 4) * 64 + 4 * hh - tq + 128;
#pragma unroll
                for (int e = 0; e < 16; ++e) {
                    const int o = (e >> 2) * 8 + (e & 3);
                    s0[e] = ((unsigned)(base + o) <= 256u) ? s0[e] : -1e30f;
                    s1[e] = ((unsigned)(base + 32 + o) <= 256u) ? s1[e] : -1e30f;
                }
            } else if (MODE == 2 && it >= 4) {
                const float* rpl = rpb_lds + (krow - rq + 7) * 31 + (4 * hh - cq + 15);
                const int vt = 4 * hh - cs_;
#pragma unroll
                for (int e = 0; e < 16; ++e) {
                    const int kcst = (e >> 2) * 8 + (e & 3);
                    const float b0 = rpl[kcst], b1 = rpl[kcst + 32];
                    s0[e] = ((unsigned)(kcst + vt) < 16u) ? (s0[e] + b0) : -1e30f;
                    s1[e] = ((unsigned)(kcst + 32 + vt) < 16u) ? (s1[e] + b1) : -1e30f;
                }
            }
            float mx = max3f(s0[0], s1[0], s0[1]);
#pragma unroll
            for (int e = 1; e < 15; ++e) mx = max3f(mx, s1[e], s0[e + 1]);
            mx = max3f(mx, s1[15], s1[15]) * LOG2E;
            if (__any(mx > mrun + 8.0f)) {
                const float mnew = max3f(mrun, mx, __shfl_xor(mx, 32));
                const float alpha = __builtin_amdgcn_exp2f(mrun - mnew);
#pragma unroll
                for (int e = 0; e < 16; ++e) { O0[e] *= alpha; O1[e] *= alpha; Lacc[e] *= alpha; }
                mrun = mnew;
            }
#pragma unroll
            for (int e = 0; e < 16; ++e) {
                s0[e] = __builtin_amdgcn_exp2f(__builtin_fmaf(s0[e], LOG2E, -mrun));
                s1[e] = __builtin_amdgcn_exp2f(__builtin_fmaf(s1[e], LOG2E, -mrun));
            }
            bf16x8 pf[2][2];
#pragma unroll
            for (int s = 0; s < 2; ++s) {
                u32x4 a, b;
                a[0] = pk2(s0[8 * s + 0], s0[8 * s + 1]); a[1] = pk2(s0[8 * s + 2], s0[8 * s + 3]); a[2] = pk2(s0[8 * s + 4], s0[8 * s + 5]); a[3] = pk2(s0[8 * s + 6], s0[8 * s + 7]);
                b[0] = pk2(s1[8 * s + 0], s1[8 * s + 1]); b[1] = pk2(s1[8 * s + 2], s1[8 * s + 3]); b[2] = pk2(s1[8 * s + 4], s1[8 * s + 5]); b[3] = pk2(s1[8 * s + 6], s1[8 * s + 7]);
                pf[0][s] = __builtin_bit_cast(bf16x8, a); pf[1][s] = __builtin_bit_cast(bf16x8, b);
            }
#pragma unroll
            for (int sub = 0; sub < 2; ++sub)
#pragma unroll
                for (int s = 0; s < 2; ++s) {
                    O0 = MFMA32(vf[0][2 * sub + s], pf[sub][s], O0);
                    O1 = MFMA32(vf[1][2 * sub + s], pf[sub][s], O1);
                    Lacc = MFMA32(ones, pf[sub][s], Lacc);
                }
        }
    }
#undef ATT_ISSUE
    const float inv = 1.0f / Lacc[0];
    const bf16_t* gp = gptr + (size_t)l31 * gstride;
    bf16_t* op = optr + (size_t)l31 * 1024;
#pragma unroll
    for (int half = 0; half < 2; ++half)
#pragma unroll
        for (int pr = 0; pr < 2; ++pr) {
            unsigned pk[4];
#pragma unroll
            for (int q = 0; q < 2; ++q) {
                const int g = 2 * pr + q, d = 32 * half + 8 * g + 4 * hh;
                const u32x2 gg = *(const u32x2*)(gp + d);
                const float a0 = (half ? O1[4 * g] : O0[4 * g]), a1 = (half ? O1[4 * g + 1] : O0[4 * g + 1]), a2 = (half ? O1[4 * g + 2] : O0[4 * g + 2]), a3 = (half ? O1[4 * g + 3] : O0[4 * g + 3]);
                pk[2 * q] = pk2(a0 * inv * bf_lo(gg[0]), a1 * inv * bf_hi(gg[0]));
                pk[2 * q + 1] = pk2(a2 * inv * bf_lo(gg[1]), a3 * inv * bf_hi(gg[1]));
            }
            store_pair16(op + 32 * half + 16 * pr, hh, pk[0], pk[1], pk[2], pk[3]);
        }
}

DI void even_mix_phase(const Params& p, int layer, char* lds, const Grp& g) {
    const int j = layer >> 1;
    const bool upd = layer < 3;
    const int w = __builtin_amdgcn_readfirstlane(otid() >> 6);
    const int local = g.local, nlocal = g.nlocal;
    const int per_b = 256 + (upd ? 32 : 0);
    for (int xcd = g.xcd; xcd < NB; xcd += g.nx)
    for (int li = local; li < per_b; li += nlocal) {
        const int item = (li < 128) ? (xcd * 128 + li) : (li < 256) ? (1024 + xcd * 128 + (li - 128)) : (2048 + xcd * 32 + (li - 256));
        if (item < 2048) {
            const bool isB = item >= 1024;
            const int it2 = item & 1023;
            const int b = it2 >> 7, kvh = (it2 >> 6) & 1, qt = it2 & 63;
            const int slot = (isB ? 2 : 0) + kvh;
            const int head = kvh * 4 + w;
            const int col = (isB ? 512 : 0) + head * 64;
            const int r0 = b * TB + CTX + qt * 32;
            const bf16_t* Kb = p.kbuf + (size_t)(b * 4 + slot) * TB * 64;
            const bf16_t* Vb = p.vT + (size_t)(b * 4 + slot) * 64 * TB;
            const bf16_t* qp = p.qbuf + (size_t)r0 * 1024 + col;
            const bf16_t* gp = p.gbuf + (size_t)r0 * 1024 + col;
            bf16_t* op = p.h + (size_t)r0 * 1024 + col;
            if (!isB) attn_block<0>(lds, Kb, Vb, 36, 0, qp, 1024, gp, 1024, op, 0.f, qt * 32, nullptr, 0);
            else {
                const int q0 = qt * 32;
                const int lo = max(0, q0 - 128) & ~63;
                const int hi = (min(SEQ, q0 + 160) + 63) & ~63;
                attn_block<1>(lds, Kb, Vb, 4 + ((hi - lo) >> 6), lo, qp, 1024, gp, 1024, op, p.b_sink[j * 8 + head] * LOG2E, q0, nullptr, 0);
            }
        } else {
            const int idx = item - 2048;
            const int b = idx >> 5, slot = (idx >> 3) & 3, qt = idx & 7;
            const bool isB = slot >= 2;
            const int head = (slot & 1) * 4 + w;
            const int col = (isB ? 512 : 0) + head * 64;
            const int r0 = b * TB + qt * 32;
            const bf16_t* Kb = p.kbuf + (size_t)(b * 4 + slot) * TB * 64;
            const bf16_t* Vb = p.vT + (size_t)(b * 4 + slot) * 64 * TB;
            const bf16_t* qp = p.qbuf + (size_t)r0 * 1024 + col;
            const bf16_t* gp = p.gbuf + (size_t)r0 * 1024 + col;
            bf16_t* op = p.h + (size_t)r0 * 1024 + col;
            if (!isB) attn_block<0>(lds, Kb, Vb, 4, 0, qp, 1024, gp, 1024, op, 0.f, 0, nullptr, 0);
            else attn_block<1>(lds, Kb, Vb, 4, 0, qp, 1024, gp, 1024, op, p.b_sink[j * 8 + head] * LOG2E, 0, nullptr, 0);
        }
    }
}

constexpr int CT = 16;
DI void conv_item(const Params& p, int j, int rbase  , int seglen, int t0, char* lds) {
    const int tid = otid(), lane = tid & 63, w = tid >> 6;
    const int c = 2 * tid;
    float wt[31][2];
    const float* wb = p.c_dw_w + (size_t)j * 31 * 512 + c;
    const bf16_t* cb = p.cbuf + (size_t)rbase * 1536 + c;
    asm volatile("" : "+v"(wb));
    asm volatile("" : "+v"(cb));
#pragma unroll
    for (int k = 0; k < 31; ++k) { const f32x2 v = *(const f32x2*)(wb + k * 512); wt[k][0] = v[0]; wt[k][1] = v[1]; }
    const f32x2 bias = *(const f32x2*)(p.c_dw_b + j * 512 + c);
    float acc[CT][2];
#pragma unroll
    for (int o = 0; o < CT; ++o) { acc[o][0] = bias[0]; acc[o][1] = bias[1]; }
#pragma unroll
    for (int i = 0; i < CT + 30; ++i) {
        const int pos = t0 - 15 + i;
        float u0 = 0.f, u1 = 0.f;
        if (pos >= 0 && pos < seglen) {
            const bf16_t* rp = cb + (ptrdiff_t)pos * 1536;
            const unsigned a = *(const unsigned*)rp, g = *(const unsigned*)(rp + 512);
            u0 = bf_lo(a) * sigmoid_f(bf_lo(g)); u1 = bf_hi(a) * sigmoid_f(bf_hi(g));
        }
#pragma unroll
        for (int o = 0; o < CT; ++o) {
            const int k = i - o;
            if (k >= 0 && k < 31) { acc[o][0] += wt[k][0] * u0; acc[o][1] += wt[k][1] * u1; }
        }
    }
    float* red = (float*)lds;
    float* stat = red + CT * 8;
    __syncthreads();
#pragma unroll
    for (int o = 0; o < CT; ++o) {
        float s1 = acc[o][0] + acc[o][1], s2 = acc[o][0] * acc[o][0] + acc[o][1] * acc[o][1];
#pragma unroll
        for (int sh = 32; sh >= 1; sh >>= 1) { s1 += __shfl_xor(s1, sh); s2 += __shfl_xor(s2, sh); }
        if (lane == 0) { red[(o * 4 + w) * 2] = s1; red[(o * 4 + w) * 2 + 1] = s2; }
    }
    __syncthreads();
    if (tid < CT) {
        float s1 = 0.f, s2 = 0.f;
#pragma unroll
        for (int q = 0; q < 4; ++q) { s1 += red[(tid * 4 + q) * 2]; s2 += red[(tid * 4 + q) * 2 + 1]; }
        const float mean = s1 * (1.0f / 512.0f);
        const float var = fmaxf(s2 * (1.0f / 512.0f) - mean * mean, 0.f);
        stat[tid * 2] = mean; stat[tid * 2 + 1] = rsqrtf(var + EPS);
    }
    __syncthreads();
    const f32x2 lg = *(const f32x2*)(p.c_ln_g + j * 512 + c), lb = *(const f32x2*)(p.c_ln_b + j * 512 + c);
#pragma unroll
    for (int o = 0; o < CT; ++o) {
        const f32x2 st = *(const f32x2*)(stat + 2 * o);
        const float mean = st[0], rstd = st[1];
        const size_t r = (size_t)(rbase + t0 + o);
        const unsigned sg = *(const unsigned*)(cb + (ptrdiff_t)(t0 + o) * 1536 + 1024);
        const float y0 = silu_f((acc[o][0] - mean) * rstd * lg[0] + lb[0]) * bf_lo(sg);
        const float y1 = silu_f((acc[o][1] - mean) * rstd * lg[1] + lb[1]) * bf_hi(sg);
        *(unsigned*)(p.h + r * 1024 + c) = pk2(y0, y1);
    }
}

DI void odd_mix_phase(const Params& p, int layer, char* lds, const Grp& g) {
    const int j = layer >> 1;
    const bool upd = layer < 3;
    const int tid = otid(), w = __builtin_amdgcn_readfirstlane(tid >> 6);
    constexpr int NCL = NB * SEQ / CT, NCC = NB * CTX / CT, I1 = 1024 + NCL, I2 = I1 + 128;
    const int total = I1 + (upd ? 128 + NCC : 0); (void)total;
    const int local = g.local, nlocal = g.nlocal;
    constexpr int PCL = NCL / NB, PCC = NCC / NB;
    const int per_b = 128 + PCL + (upd ? 16 + PCC : 0);
    float* rpb_lds = (float*)(lds + 3 * 16384) + 64;
    for (int xcd = g.xcd; xcd < NB; xcd += g.nx)
    for (int li = local; li < per_b; li += nlocal) {
        const int item = (li < 128) ? (xcd * 128 + li) : (li < 128 + PCL) ? (1024 + xcd * PCL + (li - 128)) : (li < 128 + PCL + 16) ? (I1 + xcd * 16 + (li - 128 - PCL)) : (I2 + xcd * PCC + (li - 128 - PCL - 16));
        if (item < 1024) {
            const int b = item >> 7, hd = (item >> 4) & 7, rp = item & 15;
            __syncthreads();
            for (int i = tid; i < 465 + 128; i += 256) { const int k = i - 64; rpb_lds[k] = (k >= 0 && k < 465) ? p.d_rpb[((size_t)j * 8 + hd) * 465 + k] : 0.f; }
            const int rq = 2 * rp + (w >> 1);
            const int lo_row = min(max(2 * rp - 4, 0), 24), hi_row = min(max(2 * rp + 1 - 4, 0), 24) + 8;
            const int tq0 = rq * 64 + (w & 1) * 32;
            const int r0 = b * TB + CTX + tq0;
            const bf16_t* Kb = p.kbuf + (size_t)(b * 8 + hd) * TB * 64;
            const bf16_t* Vb = p.vT + (size_t)(b * 8 + hd) * 64 * TB;
            attn_block<2>(lds, Kb, Vb, 4 + (hi_row - lo_row), lo_row * 64, p.qbuf + (size_t)r0 * 512 + hd * 64, 512, p.gbuf + (size_t)r0 * 512 + hd * 64, 512,
                          p.h + (size_t)r0 * 1024 + 512 + hd * 64, 0.f, tq0, rpb_lds, rq);
        } else if (item >= I1 && item < I2) {
            const int idx = item - I1, b = idx >> 4, hd = (idx >> 1) & 7, half = idx & 1;
            const int r0 = b * TB + half * 128 + w * 32;
            const bf16_t* Kb = p.kbuf + (size_t)(b * 8 + hd) * TB * 64;
            const bf16_t* Vb = p.vT + (size_t)(b * 8 + hd) * 64 * TB;
            attn_block<0>(lds, Kb, Vb, 4, 0, p.qbuf + (size_t)r0 * 512 + hd * 64, 512, p.gbuf + (size_t)r0 * 512 + hd * 64, 512,
                          p.h + (size_t)r0 * 1024 + 512 + hd * 64, 0.f, 0, nullptr, 0);
        } else {
            int rbase, seglen, t0;
            if (item < I1) { const int idx = item - 1024; rbase = (idx / (SEQ / CT)) * TB + CTX; seglen = SEQ; t0 = (idx % (SEQ / CT)) * CT; }
            else { const int idx = item - I2; rbase = (idx / (CTX / CT)) * TB; seglen = CTX; t0 = (idx % (CTX / CT)) * CT; }
            conv_item(p, j, rbase, seglen, t0, lds);
        }
    }
}

#ifndef PMASK
#define PMASK 0xff
#endif
DI void run_phase(const Params& p, int ph, char* lds, const Grp& g) {
    if (ph == 0) { phase0(p, lds); return; }
    if (ph == 17) { final_phase(p, g); return; }
    const int layer = (ph - 1) >> 2, sub = (ph - 1) & 3;
    if (sub == 0) norm_phase(p, layer, g);
    else if (sub == 1) gemm_in_phase(p, layer, lds, g);
    else if (sub == 2) { if (layer & 1) odd_mix_phase(p, layer, lds, g); else even_mix_phase(p, layer, lds, g); }
    else gemm_out_phase(p, layer, lds, g);
}

__global__ void __launch_bounds__(256, 2) fwd_kernel(Params p, int ph0, int ph1) {
    __shared__ __attribute__((aligned(16))) char lds[LDS_BYTES];
    __shared__ uint4 xb_words;
    XcdBarrier xb;
    const bool multi = (ph1 - ph0) > 1;
    Grp g; g.xcd = blockIdx.x & 7; g.local = blockIdx.x >> 3; g.nlocal = gridDim.x >> 3; g.nx = 8;
    if (multi) {
        if (threadIdx.x == 0) xb_words = make_uint4(0u, 0u, 0u, 0u);
        __syncthreads();
        xb = xcd_barrier_post(p.bar, (volatile LAS unsigned*)&xb_words);
    }
#ifdef CLOCK_PROBE
    const unsigned long long ct0 = __builtin_amdgcn_s_memtime(), cr0 = __builtin_amdgcn_s_memrealtime();
#endif
    for (int ph = ph0; ph < ph1; ++ph) {
        if (ph > ph0) {
            if (ph == ph0 + 1) {
                xcd_barrier(xb);
                g.nlocal = (int)xb.st[0]; g.nx = (int)xb.st[1]; g.xcd = (int)xb.st[2]; g.local = (int)xb.st[3];
            } else xcc_barrier(xb);
        }
        run_phase(p, ph, lds, g);
    }
#ifdef CLOCK_PROBE
    if (blockIdx.x == 0 && threadIdx.x == 0) {
        const unsigned long long ct1 = __builtin_amdgcn_s_memtime(), cr1 = __builtin_amdgcn_s_memrealtime();
        const unsigned long long mhz = (ct1 - ct0) * 100ull / (cr1 - cr0 + 1ull);
        const unsigned long long extra = mhz * 10ull;
        while (__builtin_amdgcn_s_memrealtime() - cr1 < extra) __builtin_amdgcn_s_sleep(8);
    }
#endif
}

extern "C" void kernel_launch(void* const* d_in, const int* in_sizes, int n_in, void* d_out, int out_size, void* d_ws, size_t ws_size, hipStream_t stream) {
    Params p{};
    p.x = (const float*)d_in[0]; p.c = (const float*)d_in[1]; p.ctx = (const float*)d_in[2]; p.c_ctx = (const float*)d_in[3];
    p.mod_w = (const float*)d_in[4]; p.mod_b = (const float*)d_in[5]; p.norm_g = (const float*)d_in[6];
    p.ev_w_in = (const float*)d_in[7]; p.ev_w_out = (const float*)d_in[8]; p.a_q_gain = (const float*)d_in[9]; p.a_k_gain = (const float*)d_in[10]; p.b_sink = (const float*)d_in[11];
    p.od_w_in = (const float*)d_in[12]; p.od_w_out = (const float*)d_in[13]; p.c_dw_w = (const float*)d_in[14]; p.c_dw_b = (const float*)d_in[15];
    p.c_ln_g = (const float*)d_in[16]; p.c_ln_b = (const float*)d_in[17]; p.d_rpb = (const float*)d_in[18]; p.final_g = (const float*)d_in[19];
    p.out = (float*)d_out;
    char* ws = (char*)d_ws; size_t off = 0;
    auto take = [&](size_t bytes) { char* r = ws + off; off += (bytes + 255) & ~(size_t)255; return r; };
    p.bar = (unsigned*)take(XCD_BAR_WORDS * 4);
    p.mvec = (float*)take((size_t)4 * 9 * 3072 * 4);
    p.rope = (float*)take((size_t)2048 * 64 * 4);
    p.wt_ev_in = (bf16_t*)take((size_t)2 * 2560 * 1024 * 2);
    p.wt_ev_out = (bf16_t*)take((size_t)2 * 1024 * 1024 * 2);
    p.wt_od_in = (bf16_t*)take((size_t)2 * 3584 * 1024 * 2);
    p.wt_od_out = (bf16_t*)take((size_t)2 * 1024 * 1024 * 2);
    p.xctx = (float*)take((size_t)NB * CTX * DM * 4);
    p.h = (bf16_t*)take((size_t)MROWS * 1024 * 2);
    p.qbuf = (bf16_t*)take((size_t)MROWS * 1024 * 2);
    p.gbuf = (bf16_t*)take((size_t)MROWS * 1024 * 2);
    p.cbuf = (bf16_t*)take((size_t)MROWS * 1536 * 2);
    p.kbuf = (bf16_t*)take((size_t)NB * 8 * TB * 64 * 2);
    p.vT = (bf16_t*)take((size_t)NB * 8 * 64 * TB * 2);
    if (off > ws_size) { fprintf(stderr, "workspace too small: need %zu have %zu\n", off, ws_size); return; }

    static int grid_blocks = 0;
    if (!grid_blocks) {
        int dev = 0, cus = 0, per_cu = 0;
        hipGetDevice(&dev);
        hipDeviceGetAttribute(&cus, hipDeviceAttributeMultiprocessorCount, dev);
        hipOccupancyMaxActiveBlocksPerMultiprocessor(&per_cu, fwd_kernel, 256, 0);
        if (per_cu > 2) per_cu = 2;
        if (per_cu < 1) per_cu = 1;
        grid_blocks = cus * per_cu;
        grid_blocks &= ~7;
    }
#if MULTI_LAUNCH
    for (int ph = 0; ph < 18; ++ph) hipLaunchKernelGGL(fwd_kernel, dim3(grid_blocks), dim3(256), 0, stream, p, ph, ph + 1);
#else
    hipMemsetAsync(p.bar, 0, XCD_BAR_WORDS * 4, stream);
    int ph0 = 0, ph1 = 18;
    void* args[] = {&p, &ph0, &ph1};
    hipError_t e = hipLaunchCooperativeKernel((void*)fwd_kernel, dim3(grid_blocks), dim3(256), args, 0, stream);
    if (e != hipSuccess) fprintf(stderr, "cooperative launch failed: %s (grid %d)\n", hipGetErrorString(e), grid_blocks);
#endif
}
```

```cpp
#include <hip/hip_runtime.h>
#include <hip/hip_cooperative_groups.h>
#include <cstdint>
#include <cstdio>

#ifndef MULTI_LAUNCH
#define MULTI_LAUNCH 0
#endif

#define DI __device__ __forceinline__
#define LAS __attribute__((address_space(3)))

typedef unsigned short bf16_t;
typedef short bf16x8 __attribute__((ext_vector_type(8)));
typedef float f32x16 __attribute__((ext_vector_type(16)));
typedef float f32x4 __attribute__((ext_vector_type(4)));
typedef float f32x2 __attribute__((ext_vector_type(2)));
typedef unsigned u32x4 __attribute__((ext_vector_type(4)));
typedef unsigned u32x2 __attribute__((ext_vector_type(2)));
typedef __bf16 bf16v2 __attribute__((ext_vector_type(2)));

constexpr int NB = 8, SEQ = 2048, DM = 1024, CTX = 256, TB = 2304, MROWS = NB * TB;
constexpr float EPS = 1e-6f, LOG2E = 1.4426950408889634f;
constexpr int LROW = 144;
constexpr int GT_BYTES = 128 * LROW;
constexpr int LDS_BYTES = 73728;

struct Params {
    const float *x, *c, *ctx, *c_ctx, *mod_w, *mod_b, *norm_g, *ev_w_in, *ev_w_out, *a_q_gain, *a_k_gain, *b_sink,
        *od_w_in, *od_w_out, *c_dw_w, *c_dw_b, *c_ln_g, *c_ln_b, *d_rpb, *final_g;
    float* out;
    unsigned* bar;
    float* mvec;
    float* rope;
    bf16_t *wt_ev_in, *wt_ev_out, *wt_od_in, *wt_od_out;
    float* xctx;
    bf16_t* h;
    bf16_t* qbuf;
    bf16_t* gbuf;
    bf16_t* cbuf;
    bf16_t* kbuf;
    bf16_t* vT;
};

DI unsigned pk2(float a, float b) { f32x2 v = {a, b}; bf16v2 r = __builtin_convertvector(v, bf16v2); return __builtin_bit_cast(unsigned, r); }
DI float bf_lo(unsigned u) { return __uint_as_float(u << 16); }
DI float bf_hi(unsigned u) { return __uint_as_float(u & 0xffff0000u); }
DI float silu_f(float x) { return x * __builtin_amdgcn_rcpf(1.f + __builtin_amdgcn_exp2f(-LOG2E * x)); }
DI float sigmoid_f(float x) { return __builtin_amdgcn_rcpf(1.f + __builtin_amdgcn_exp2f(-LOG2E * x)); }
DI int otid() { int t = threadIdx.x; asm volatile("" : "+v"(t)); return t; }
DI float max3f(float a, float b, float c) { float r; asm("v_max3_f32 %0, %1, %2, %3" : "=v"(r) : "v"(a), "v"(b), "v"(c)); return r; }
#define MFMA32(a, b, c) __builtin_amdgcn_mfma_f32_32x32x16_bf16((a), (b), (c), 0, 0, 0)

DI const float* res_in_row(const Params& p, int layer, int r) {
    const int b = r / TB, t = r - b * TB;
    if (t < CTX) return (layer == 0 ? p.ctx : (const float*)p.xctx) + (size_t)(b * CTX + t) * DM;
    return (layer == 0 ? p.x : (const float*)p.out) + (size_t)(b * SEQ + t - CTX) * DM;
}
DI float* res_out_row(const Params& p, int r) {
    const int b = r / TB, t = r - b * TB;
    if (t < CTX) return p.xctx + (size_t)(b * CTX + t) * DM;
    return p.out + (size_t)(b * SEQ + t - CTX) * DM;
}

#define XB_TMO      128
#define XB_XCNT(j)  (256  + 64 * (j))
#define XB_XSUB(j)  (1280 + 64 * (j))
#define XB_XGEN(j)  (2304 + 64 * (j))
#define XB_TOP      3328
#define XB_TOPGEN   3392
#define XB_LSUB(j)  (3456 + 64 * (j))
#define XB_LGEN(j)  (4480 + 64 * (j))
#define XCD_BAR_WORDS 5504
#define XB_SPIN_CAP (1u << 22)
DI unsigned xb_ld(unsigned* p) { return __hip_atomic_load(p, __ATOMIC_RELAXED, __HIP_MEMORY_SCOPE_AGENT); }
DI unsigned xb_add(unsigned* p, unsigned v) { return __hip_atomic_fetch_add(p, v, __ATOMIC_RELAXED, __HIP_MEMORY_SCOPE_AGENT); }
DI unsigned xb_xcc_id() { return (unsigned)__builtin_amdgcn_s_getreg((3 << 11) | 20) & 0xFu; }
#define XB_SPIN(cond, bar) do { unsigned _sp = 0; while (cond) { __builtin_amdgcn_s_sleep(1); \
    if ((++_sp & 255u) == 0u) { if (xb_ld(&(bar)[XB_TMO])) break; if (_sp > XB_SPIN_CAP) { atomicAdd(&(bar)[XB_TMO], 1u); break; } } } } while (0)
struct XcdBarrier { unsigned* bar; unsigned x; volatile LAS unsigned* st; };
DI XcdBarrier xcd_barrier_post(unsigned* bar, volatile LAS unsigned* st) {
    XcdBarrier b; b.bar = bar; b.x = xb_xcc_id(); b.st = st;
    if (threadIdx.x == 0) st[3] = xb_add(&bar[XB_XCNT(b.x)], 1u);
    return b;
}
DI void xcd_barrier_complete(unsigned* bar, unsigned x, unsigned& nloc, unsigned& nx, unsigned& xidx) {
    const unsigned G = gridDim.x * gridDim.y * gridDim.z;
    unsigned sum, cnt, mine, below, sp = 0u;
    for (;;) {
        sum = 0u; cnt = 0u; mine = 0u; below = 0u;
#pragma unroll
        for (unsigned j = 0; j < 16; ++j) { const unsigned c = xb_ld(&bar[XB_XCNT(j)]); sum += c; cnt += (c > 0u) ? 1u : 0u; mine = (j == x) ? c : mine; below += (c > 0u && j < x) ? 1u : 0u; }
        if (sum == G) break;
        __builtin_amdgcn_s_sleep(1);
        if ((++sp & 255u) == 0u) { if (xb_ld(&bar[XB_TMO])) break; if (sp > XB_SPIN_CAP) { atomicAdd(&bar[XB_TMO], 1u); break; } }
    }
    nloc = mine > 0u ? mine : 1u; nx = cnt > 0u ? cnt : 1u; xidx = below;
}
DI void xcd_barrier(const XcdBarrier& b) {
    asm volatile("s_waitcnt vmcnt(0)" ::: "memory");
    __syncthreads();
    if (threadIdx.x == 0) {
        unsigned* bar = b.bar;
        asm volatile("" : "+s"(bar));
        __builtin_amdgcn_s_waitcnt(0);
        unsigned nloc = b.st[0], nx = b.st[1];
        if (nloc == 0u) { unsigned xidx; xcd_barrier_complete(bar, b.x, nloc, nx, xidx); b.st[0] = nloc; b.st[1] = nx; b.st[2] = xidx; }
        const unsigned old = xb_add(&bar[XB_XSUB(b.x)], 1u);
        const unsigned gen = old / nloc;
        if (old + 1u == (gen + 1u) * nloc) {
            __builtin_amdgcn_fence(__ATOMIC_RELEASE, "agent");
            asm volatile("s_waitcnt vmcnt(0)" ::: "memory");
            const unsigned og = xb_add(&bar[XB_TOP], 1u);
            const unsigned tg = og / nx;
            if (og + 1u == (tg + 1u) * nx) xb_add(&bar[XB_TOPGEN], 1u);
            else XB_SPIN(xb_ld(&bar[XB_TOPGEN]) == tg, bar);
            __builtin_amdgcn_fence(__ATOMIC_ACQUIRE, "agent");
            xb_add(&bar[XB_XGEN(b.x)], 1u);
            asm volatile("s_waitcnt vmcnt(0)" ::: "memory");
        } else {
            XB_SPIN(xb_ld(&bar[XB_XGEN(b.x)]) == gen, bar);
            __builtin_amdgcn_fence(__ATOMIC_ACQUIRE, "agent");
            asm volatile("s_waitcnt vmcnt(0)" ::: "memory");
        }
    }
    __syncthreads();
}

DI void xcc_barrier(const XcdBarrier& b) {
    asm volatile("s_waitcnt vmcnt(0)" ::: "memory");
    __syncthreads();
    if (threadIdx.x == 0) {
        unsigned* bar = b.bar;
        asm volatile("" : "+s"(bar));
        __builtin_amdgcn_s_waitcnt(0);
        const unsigned nloc = b.st[0];
        const unsigned old = xb_add(&bar[XB_LSUB(b.x)], 1u);
        const unsigned gen = old / nloc;
        if (old + 1u == (gen + 1u) * nloc) xb_add(&bar[XB_LGEN(b.x)], 1u);
        else XB_SPIN(xb_ld(&bar[XB_LGEN(b.x)]) == gen, bar);
        __builtin_amdgcn_fence(__ATOMIC_ACQUIRE, "agent");
        asm volatile("s_waitcnt vmcnt(0)" ::: "memory");
    }
    __syncthreads();
}

struct Grp { int xcd, local, nlocal, nx; };

DI void mod_item(const Params& p, char* lds, int item) {
    const int tid = otid();
    const int layer = item / 48, n0 = (item % 48) * 64;
    float* sc = (float*)lds;
    float* part = (float*)(lds + 36864);
    __syncthreads();
    for (int i = tid; i < 9 * 1024; i += 256) { const int j = i >> 10, k = i & 1023; const float v = (j < 8) ? p.c[j * 1024 + k] : p.c_ctx[k]; sc[i] = silu_f(v); }
    __syncthreads();
    const int kg = tid >> 4, c4 = (tid & 15) * 4;
    f32x4 acc[9];
#pragma unroll
    for (int j = 0; j < 9; ++j) acc[j] = (f32x4){0.f, 0.f, 0.f, 0.f};
    const float* wp = p.mod_w + ((size_t)layer * 1024 + kg * 64) * 3072 + n0 + c4;
    const float* scp = sc + kg * 64;
#pragma unroll 16
    for (int k = 0; k < 64; ++k) {
        const f32x4 wv = *(const f32x4*)(wp + (size_t)k * 3072);
#pragma unroll
        for (int j = 0; j < 9; ++j) { const float sv = scp[j * 1024 + k]; acc[j] += wv * sv; }
    }
#pragma unroll
    for (int j = 0; j < 9; ++j) *(f32x4*)(part + (kg * 9 + j) * 64 + c4) = acc[j];
    __syncthreads();
    for (int i = tid; i < 9 * 64; i += 256) {
        const int j = i >> 6, cc = i & 63;
        float sm = p.mod_b[layer * 3072 + n0 + cc];
#pragma unroll
        for (int g = 0; g < 16; ++g) sm += part[(g * 9 + j) * 64 + cc];
        p.mvec[((size_t)layer * 9 + j) * 3072 + n0 + cc] = sm;
    }
}

DI void rope_item(const Params& p, int item) {
    const int idx = item * 256 + otid();
    const int t = idx >> 5, pp = idx & 31;
    const float pos = (float)((pp < 16) ? (t >> 6) : (t & 63));
    const float freq = powf(10000.0f, -(float)(pp & 15) / 16.0f);
    const float ang = pos * freq;
    float sn, cs; sincosf(ang, &sn, &cs);
    *(f32x2*)(p.rope + (size_t)idx * 2) = (f32x2){cs, sn};
}

DI void wconv_item(const float* __restrict__ W, bf16_t* __restrict__ Wt, int N, int tile, char* lds, bool glu = false) {
    const int tid = otid();
    const int ntn = N >> 6, kt = tile / ntn, nt_ = tile - kt * ntn, k0 = kt * 64, n0 = nt_ * 64;
    float* tl = (float*)lds;
    __syncthreads();
#pragma unroll
    for (int j = 0; j < 4; ++j) {
        const int kk = (tid >> 4) + 16 * j, nn = (tid & 15) * 4;
        int src = n0 + nn;
        if (glu && n0 < 1024) src = ((nn & 32) ? 512 : 0) + (n0 >> 1) + (nn & 31);
        const f32x4 v = *(const f32x4*)(W + (size_t)(k0 + kk) * N + src);
        tl[kk * 65 + nn + 0] = v[0]; tl[kk * 65 + nn + 1] = v[1]; tl[kk * 65 + nn + 2] = v[2]; tl[kk * 65 + nn + 3] = v[3];
    }
    __syncthreads();
#pragma unroll
    for (int j = 0; j < 2; ++j) {
        const int idx = tid + 256 * j, n = idx >> 3, kc = (idx & 7) * 8;
        u32x4 o;
        o[0] = pk2(tl[(kc + 0) * 65 + n], tl[(kc + 1) * 65 + n]);
        o[1] = pk2(tl[(kc + 2) * 65 + n], tl[(kc + 3) * 65 + n]);
        o[2] = pk2(tl[(kc + 4) * 65 + n], tl[(kc + 5) * 65 + n]);
        o[3] = pk2(tl[(kc + 6) * 65 + n], tl[(kc + 7) * 65 + n]);
        *(u32x4*)(Wt + (size_t)(n0 + n) * 1024 + k0 + kc) = o;
    }
}

DI void wconv_tile(const Params& p, char* lds, int t) {
    int w = t; const int j = w >> 11; w &= 2047;
    if (w < 640) wconv_item(p.ev_w_in + (size_t)j * 1024 * 2560, p.wt_ev_in + (size_t)j * 2560 * 1024, 2560, w, lds);
    else if (w < 896) wconv_item(p.ev_w_out + (size_t)j * 1024 * 1024, p.wt_ev_out + (size_t)j * 1024 * 1024, 1024, w - 640, lds);
    else if (w < 1792) wconv_item(p.od_w_in + (size_t)j * 1024 * 3584, p.wt_od_in + (size_t)j * 3584 * 1024, 3584, w - 896, lds, true);
    else wconv_item(p.od_w_out + (size_t)j * 1024 * 1024, p.wt_od_out + (size_t)j * 1024 * 1024, 1024, w - 1792, lds);
}
DI void phase0(const Params& p, char* lds) {
    const int G = gridDim.x, b = blockIdx.x;
    if (G >= 448) {
        if (b < 192) mod_item(p, lds, b);
        else if (b < 448) rope_item(p, b - 192);
        if (b < 192) { for (int k = 0; k < 4; ++k) wconv_tile(p, lds, b + 192 * k); }
        else { for (int t = 768 + (b - 192); t < 4096; t += G - 192) wconv_tile(p, lds, t); }
    } else {
        const int total = 192 + 256 + 4096;
        for (int item = b; item < total; item += G) {
            if (item < 192) mod_item(p, lds, item);
            else if (item < 448) rope_item(p, item - 192);
            else wconv_tile(p, lds, item - 448);
        }
    }
}

DI void norm_phase(const Params& p, int layer, const Grp& grp) {
    const int lane = otid() & 63, w = otid() >> 6;
    const float* g = p.norm_g + layer * 1024;
    const int local = grp.local, nlocal = grp.nlocal;
    for (int xcd = grp.xcd; xcd < NB; xcd += grp.nx)
#pragma unroll 1
        for (int seg = 0; seg < 2; ++seg) {
            const int cond = seg ? xcd : 8;
            const float* mv = p.mvec + ((size_t)layer * 9 + cond) * 3072;
            f32x4 mul[4], add[4];
#pragma unroll
            for (int j = 0; j < 4; ++j) {
                const int c0 = lane * 4 + 256 * j;
                const f32x4 gg = *(const f32x4*)(g + c0), sh = *(const f32x4*)(mv + c0), sc = *(const f32x4*)(mv + 1024 + c0);
#pragma unroll
                for (int e = 0; e < 4; ++e) { mul[j][e] = gg[e] * (1.f + sc[e]); add[j][e] = sh[e]; }
            }
            const int i0 = seg ? CTX / 4 : 0, i1 = seg ? TB / 4 : CTX / 4;
            for (int li = i0 + local; li < i1; li += nlocal) {
                const int r = (xcd * (TB / 4) + li) * 4 + w;
                const float* xr = res_in_row(p, layer, r);
                f32x4 v[4]; float ss = 0.f;
#pragma unroll
                for (int j = 0; j < 4; ++j) { v[j] = *(const f32x4*)(xr + lane * 4 + 256 * j); ss += v[j][0] * v[j][0] + v[j][1] * v[j][1] + v[j][2] * v[j][2] + v[j][3] * v[j][3]; }
#pragma unroll
                for (int o = 32; o >= 1; o >>= 1) ss += __shfl_xor(ss, o);
                const float rstd = rsqrtf(ss * (1.0f / 1024.0f) + EPS);
                bf16_t* hr = p.h + (size_t)r * 1024;
#pragma unroll
                for (int j = 0; j < 4; ++j) {
                    const int c0 = lane * 4 + 256 * j;
                    float y[4];
#pragma unroll
                    for (int e = 0; e < 4; ++e) y[e] = (v[j][e] * rstd) * mul[j][e] + add[j][e];
                    *(u32x2*)(hr + c0) = (u32x2){pk2(y[0], y[1]), pk2(y[2], y[3])};
                }
            }
        }
}

DI void final_phase(const Params& p, const Grp& g) {
    const int lane = otid() & 63, w = otid() >> 6;
    const int local = g.local, nlocal = g.nlocal;
    f32x4 fg[4];
#pragma unroll
    for (int j = 0; j < 4; ++j) fg[j] = *(const f32x4*)(p.final_g + lane * 4 + 256 * j);
    for (int xcd = g.xcd; xcd < NB; xcd += g.nx)
    for (int li = local; li < SEQ / 4; li += nlocal) {
        const int item = xcd * (SEQ / 4) + li;
        const int r = item * 4 + w;
        float* xr = p.out + (size_t)r * 1024;
        f32x4 v[4]; float ss = 0.f;
#pragma unroll
        for (int j = 0; j < 4; ++j) { v[j] = *(const f32x4*)(xr + lane * 4 + 256 * j); ss += v[j][0] * v[j][0] + v[j][1] * v[j][1] + v[j][2] * v[j][2] + v[j][3] * v[j][3]; }
#pragma unroll
        for (int o = 32; o >= 1; o >>= 1) ss += __shfl_xor(ss, o);
        const float rstd = rsqrtf(ss * (1.0f / 1024.0f) + EPS);
#pragma unroll
        for (int j = 0; j < 4; ++j) {
            const int c0 = lane * 4 + 256 * j;
            f32x4 o;
#pragma unroll
            for (int e = 0; e < 4; ++e) o[e] = v[j][e] * rstd * fg[j][e];
            *(f32x4*)(xr + c0) = o;
        }
    }
}

DI void dma16(const void* gsrc, unsigned lds_dst) { unsigned keep;
    asm volatile("s_mov_b32 %0, m0\n\ts_mov_b32 m0, %2\n\ts_nop 0\n\tglobal_load_lds_dwordx4 %1, off\n\ts_mov_b32 m0, %0" : "=&s"(keep) : "v"(gsrc), "s"(lds_dst) : "memory"); }
DI void dma16s(const void* base, unsigned voff, unsigned lds_dst) { unsigned keep;
    asm volatile("s_mov_b32 %0, m0\n\ts_mov_b32 m0, %3\n\ts_nop 0\n\tglobal_load_lds_dwordx4 %1, %2\n\ts_mov_b32 m0, %0" : "=&s"(keep) : "v"(voff), "s"(base), "s"(lds_dst) : "memory"); }
#define WAIT_BAR(N) asm volatile("s_waitcnt vmcnt(" #N ") lgkmcnt(0)\n\ts_barrier" ::: "memory")
#define WAIT_VM(n) asm volatile("s_waitcnt vmcnt(" #n ")" ::: "memory")

template <bool SWAP, int TI, int GP = 0>
DI void gemm_mainloop(const bf16_t* __restrict__ A, const bf16_t* __restrict__ W, int row0, int col0, f32x16 (&acc)[2 * TI], char* lds, bool pre_issued) {
    constexpr int MT = 64 * TI, STAGE = (MT + 128) * 64, NST = (TI == 4) ? 3 : 4, NA = TI, KT = 32;
    const int tid = otid(), lane = tid & 63, w = __builtin_amdgcn_readfirstlane(tid >> 6), wm = w >> 1, wn = w & 1, l31 = lane & 31, hh = lane >> 5;
    const int cc = (lane & 3) ^ ((lane >> 4) & 3);
    const unsigned pa = (unsigned)(((row0 + 16 * w + (lane >> 2)) * 1024 + cc * 8) * 2);
    const unsigned pb = (unsigned)(((col0 + 16 * w + (lane >> 2)) * 1024 + cc * 8) * 2);
    const unsigned l3 = (unsigned)(size_t)lds + w * 1024;
    const int sw = (l31 >> 2) & 3;
    const char* fa = lds + (wm * (32 * TI) + l31) * 64;
    const char* fb = lds + MT * 64 + (wn * 64 + l31) * 64;
    const int ch0 = ((0 + hh) ^ sw) * 16, ch1 = ((2 + hh) ^ sw) * 16;
#pragma unroll
    for (int i = 0; i < 2 * TI; ++i)
#pragma unroll
        for (int e = 0; e < 16; ++e) acc[i][e] = 0.f;
    if (!pre_issued) WAIT_BAR(0);
#define GEMM_ISSUE(kt, st) do { const unsigned _sb = l3 + (st) * STAGE; const int _ko = (kt) * 32; \
        _Pragma("unroll") for (int _j = 0; _j < NA; ++_j) dma16s(A, pa + (_j * 64 * 1024 + _ko) * 2, _sb + _j * 4096); \
        _Pragma("unroll") for (int _j = 0; _j < 2; ++_j) dma16s(W, pb + (_j * 64 * 1024 + _ko) * 2, _sb + MT * 64 + _j * 4096); } while (0)
#define GEMM_STAGE(DO_ISSUE, ktn) do { \
        const char* sa = fa + rs * STAGE; const char* sb = fb + rs * STAGE; \
        const unsigned _sbase = l3 + is * STAGE; const int _ko = (ktn) * 32; \
        bf16x8 af[2][TI], bf[2][2]; \
        _Pragma("unroll") for (int ks = 0; ks < 2; ++ks) { const int ch = ks ? ch1 : ch0; \
            _Pragma("unroll") for (int i = 0; i < TI; ++i) af[ks][i] = *(const bf16x8*)(sa + i * 32 * 64 + ch); \
            _Pragma("unroll") for (int j = 0; j < 2; ++j) bf[ks][j] = *(const bf16x8*)(sb + j * 32 * 64 + ch); } \
        _Pragma("unroll") for (int m = 0; m < 4 * TI; ++m) { \
            const int ks = m / (2 * TI), i = (m % (2 * TI)) >> 1, j = m & 1; \
            if (SWAP) acc[i * 2 + j] = MFMA32(af[ks][i], bf[ks][j], acc[i * 2 + j]); \
            else      acc[j * TI + i] = MFMA32(bf[ks][j], af[ks][i], acc[j * TI + i]); \
            if (DO_ISSUE && (m & 1) && (m >> 1) < NA + 2) { const int q = m >> 1; \
                __builtin_amdgcn_sched_barrier(0); \
                if (q < NA) dma16s(A, pa + (q * 64 * 1024 + _ko) * 2, _sbase + q * 4096); \
                else dma16s(W, pb + ((q - NA) * 64 * 1024 + _ko) * 2, _sbase + MT * 64 + (q - NA) * 4096); \
                __builtin_amdgcn_sched_barrier(0); } } \
        rs = (rs + 1 == NST) ? 0 : rs + 1; } while (0)
    if (TI == 2) {
        if (!pre_issued) { GEMM_ISSUE(0, 0); GEMM_ISSUE(1, 1); }
        int rs = 0, is = 2;
#pragma unroll 1
        for (int kp = 0; kp < KT / 2 - 1; ++kp) {
            WAIT_BAR(0);
            GEMM_STAGE(true, 2 * kp + 2);
            is = (is + 1) & 3;
            GEMM_STAGE(true, 2 * kp + 3);
            is = (is + 1) & 3;
        }
        WAIT_BAR(0);
        GEMM_STAGE(false, 0);
        GEMM_STAGE(false, 0);
    } else {
    if (!pre_issued) {
#pragma unroll
        for (int s = 0; s < NST - 1; ++s) GEMM_ISSUE(s, s);
    }
    int rs = 0, is = NST - 1;
#pragma unroll 1
    for (int kt = 0; kt < KT - (NST - 1); ++kt) {
        if (TI == 4) WAIT_BAR(6); else WAIT_BAR(8);
        GEMM_STAGE(true, kt + NST - 1);
        is = (is + 1 == NST) ? 0 : is + 1;
    }
#pragma unroll 1
    for (int kt = KT - (NST - 1); kt < KT; ++kt) {
        WAIT_BAR(0);
        GEMM_STAGE(false, 0);
    }
    }
#undef GEMM_STAGE
#undef GEMM_ISSUE
}

template <int TI>
DI void gemm_prefetch(const bf16_t* __restrict__ A, const bf16_t* __restrict__ W, int row0, int col0, char* lds) {
    constexpr int MT = 64 * TI, STAGE = (MT + 128) * 64, NST = (TI == 4) ? 3 : 4, NA = TI;
    const int tid = otid(), lane = tid & 63, w = __builtin_amdgcn_readfirstlane(tid >> 6);
    const int cc = (lane & 3) ^ ((lane >> 4) & 3);
    const unsigned pa = (unsigned)(((row0 + 16 * w + (lane >> 2)) * 1024 + cc * 8) * 2);
    const unsigned pb = (unsigned)(((col0 + 16 * w + (lane >> 2)) * 1024 + cc * 8) * 2);
    const unsigned l3 = (unsigned)(size_t)lds + w * 1024;
    asm volatile("s_waitcnt lgkmcnt(0)\n\ts_barrier" ::: "memory");
#pragma unroll
    for (int s = 0; s < ((TI == 2) ? 2 : NST - 1); ++s) {
        const unsigned sb = l3 + s * STAGE; const int ko = s * 32;
#pragma unroll
        for (int j = 0; j < NA; ++j) dma16s(A, pa + (j * 64 * 1024 + ko) * 2, sb + j * 4096);
#pragma unroll
        for (int j = 0; j < 2; ++j) dma16s(W, pb + (j * 64 * 1024 + ko) * 2, sb + MT * 64 + j * 4096);
    }
}

DI void store_pair16(bf16_t* pairp  , int hh, unsigned a0, unsigned a1, unsigned b0, unsigned b1) {
    const u32x2 r0 = __builtin_amdgcn_permlane32_swap(a0, b0, false, false);
    const u32x2 r1 = __builtin_amdgcn_permlane32_swap(a1, b1, false, false);
    *(u32x4*)(pairp + 8 * hh) = (u32x4){r0[0], r1[0], r0[1], r1[1]};
}

template <int TR, int TI>
DI void epi_plain(const f32x16 (&acc)[2 * TI], bf16_t* dst, int stride, int row0) {
    const int lane = otid() & 63, w = __builtin_amdgcn_readfirstlane(otid() >> 6), wm = w >> 1, l31 = lane & 31, hh = lane >> 5;
#pragma unroll
    for (int ti = 0; ti < TI; ++ti) {
        const int r = row0 + wm * (32 * TI) + 32 * ti + l31;
        bf16_t* rp = dst + (size_t)r * stride;
#pragma unroll
        for (int fi = 0; fi < 2; ++fi)
#pragma unroll
            for (int gp = 0; gp < 2; ++gp) {
                float v[8];
#pragma unroll
                for (int e = 0; e < 8; ++e) { float x = acc[fi * TI + ti][8 * gp + e]; if (TR == 1) x = silu_f(x); if (TR == 2) x *= 0.125f; v[e] = x; }
                store_pair16(rp + 32 * fi + 16 * gp, hh, pk2(v[0], v[1]), pk2(v[2], v[3]), pk2(v[4], v[5]), pk2(v[6], v[7]));
            }
    }
}

template <int TI>
DI void epi_glu(const f32x16 (&acc)[2 * TI], bf16_t* dst  , int row0) {
    const int lane = otid() & 63, w = __builtin_amdgcn_readfirstlane(otid() >> 6), wm = w >> 1, l31 = lane & 31, hh = lane >> 5;
#pragma unroll
    for (int ti = 0; ti < TI; ++ti) {
        const int r = row0 + wm * (32 * TI) + 32 * ti + l31;
        bf16_t* rp = dst + (size_t)r * 1536;
#pragma unroll
        for (int gp = 0; gp < 2; ++gp) {
            float v[8];
#pragma unroll
            for (int e = 0; e < 8; ++e) v[e] = acc[0 * TI + ti][8 * gp + e] * sigmoid_f(acc[1 * TI + ti][8 * gp + e]);
            store_pair16(rp + 16 * gp, hh, pk2(v[0], v[1]), pk2(v[2], v[3]), pk2(v[4], v[5]), pk2(v[6], v[7]));
        }
    }
}

template <bool RMS, bool ISQ, int TI>
DI void epi_qk(const Params& p, const f32x16 (&acc)[2 * TI], const float* gain, int row0, bf16_t* qdst  , int kslot, int nkv) {
    const int lane = otid() & 63, w = __builtin_amdgcn_readfirstlane(otid() >> 6), wm = w >> 1, l31 = lane & 31, hh = lane >> 5;
#pragma unroll
    for (int ti = 0; ti < TI; ++ti) {
        const int r = row0 + wm * (32 * TI) + 32 * ti + l31;
        const int b = r / TB, t = r - b * TB;
        float v[2][16];
#pragma unroll
        for (int fi = 0; fi < 2; ++fi)
#pragma unroll
            for (int e = 0; e < 16; ++e) v[fi][e] = acc[fi * TI + ti][e];
        if (RMS) {
            float ss = 0.f;
#pragma unroll
            for (int fi = 0; fi < 2; ++fi)
#pragma unroll
                for (int e = 0; e < 16; ++e) ss += v[fi][e] * v[fi][e];
            ss += __shfl_xor(ss, 32);
            const float rstd = rsqrtf(ss * (1.0f / 64.0f) + EPS);
#pragma unroll
            for (int fi = 0; fi < 2; ++fi)
#pragma unroll
                for (int g = 0; g < 4; ++g) {
                    const f32x4 gg = *(const f32x4*)(gain + 32 * fi + 8 * g + 4 * hh);
#pragma unroll
                    for (int e = 0; e < 4; ++e) v[fi][4 * g + e] = v[fi][4 * g + e] * rstd * gg[e];
                }
        }
        if (t >= CTX) {
            const float* rt = p.rope + (size_t)(t - CTX) * 64;
#pragma unroll
            for (int fi = 0; fi < 2; ++fi)
#pragma unroll
                for (int g = 0; g < 4; ++g) {
                    const f32x4 cs = *(const f32x4*)(rt + (16 * fi + 4 * g + 2 * hh) * 2);
                    const float x0 = v[fi][4 * g + 0], x1 = v[fi][4 * g + 1], x2 = v[fi][4 * g + 2], x3 = v[fi][4 * g + 3];
                    v[fi][4 * g + 0] = x0 * cs[0] - x1 * cs[1];
                    v[fi][4 * g + 1] = x0 * cs[1] + x1 * cs[0];
                    v[fi][4 * g + 2] = x2 * cs[2] - x3 * cs[3];
                    v[fi][4 * g + 3] = x2 * cs[3] + x3 * cs[2];
                }
        }
        bf16_t* rp = ISQ ? (qdst + (size_t)r * 1024) : (p.kbuf + ((size_t)(b * nkv + kslot) * TB + t) * 64);
#pragma unroll
        for (int fi = 0; fi < 2; ++fi)
#pragma unroll
            for (int gp = 0; gp < 2; ++gp) {
                float o[8];
#pragma unroll
                for (int e = 0; e < 8; ++e) o[e] = ISQ ? v[fi][8 * gp + e] * 0.125f : v[fi][8 * gp + e];
                store_pair16(rp + 32 * fi + 16 * gp, hh, pk2(o[0], o[1]), pk2(o[2], o[3]), pk2(o[4], o[5]), pk2(o[6], o[7]));
            }
    }
}

template <int TI>
DI void epi_k_plain(const Params& p, const f32x16 (&acc)[2 * TI], int row0, int kslot, int nkv) {
    const int lane = otid() & 63, w = __builtin_amdgcn_readfirstlane(otid() >> 6), wm = w >> 1, l31 = lane & 31, hh = lane >> 5;
#pragma unroll
    for (int ti = 0; ti < TI; ++ti) {
        const int r = row0 + wm * (32 * TI) + 32 * ti + l31;
        const int b = r / TB, t = r - b * TB;
        bf16_t* rp = p.kbuf + ((size_t)(b * nkv + kslot) * TB + t) * 64;
#pragma unroll
        for (int fi = 0; fi < 2; ++fi)
#pragma unroll
            for (int gp = 0; gp < 2; ++gp)
                store_pair16(rp + 32 * fi + 16 * gp, hh, pk2(acc[fi * TI + ti][8 * gp], acc[fi * TI + ti][8 * gp + 1]), pk2(acc[fi * TI + ti][8 * gp + 2], acc[fi * TI + ti][8 * gp + 3]),
                             pk2(acc[fi * TI + ti][8 * gp + 4], acc[fi * TI + ti][8 * gp + 5]), pk2(acc[fi * TI + ti][8 * gp + 6], acc[fi * TI + ti][8 * gp + 7]));
    }
}

template <int TI>
DI void epi_v(const Params& p, const f32x16 (&acc)[2 * TI], int row0, int vslot, int nkv) {
    const int lane = otid() & 63, w = __builtin_amdgcn_readfirstlane(otid() >> 6), wm = w >> 1, l31 = lane & 31, hh = lane >> 5;
#pragma unroll
    for (int ti = 0; ti < TI; ++ti) {
        const int rb = row0 + wm * (32 * TI) + 32 * ti;
        const int b = rb / TB, tb = rb - b * TB;
#pragma unroll
        for (int fi = 0; fi < 2; ++fi) {
            const int d = 32 * fi + l31;
            bf16_t* vp = p.vT + ((size_t)(b * nkv + vslot) * 64 + d) * TB + tb;
#pragma unroll
            for (int gq = 0; gq < 2; ++gq) {
                u32x4 o;
                o[0] = pk2(acc[ti * 2 + fi][8 * gq + 0], acc[ti * 2 + fi][8 * gq + 1]);
                o[1] = pk2(acc[ti * 2 + fi][8 * gq + 2], acc[ti * 2 + fi][8 * gq + 3]);
                o[2] = pk2(acc[ti * 2 + fi][8 * gq + 4], acc[ti * 2 + fi][8 * gq + 5]);
                o[3] = pk2(acc[ti * 2 + fi][8 * gq + 6], acc[ti * 2 + fi][8 * gq + 7]);
                *(u32x4*)(vp + 16 * gq + 8 * hh) = o;
            }
        }
    }
}

#ifndef GPROBE
#define GPROBE 0
#endif
constexpr int TIN = 4;
DI void gemm_in_phase(const Params& p, int layer, char* lds, const Grp& g, bool do_epi = true) {
    const bool even = (layer & 1) == 0;
    const int j = layer >> 1;
    const int N = even ? 2560 : 3584, nct = N / 128;
    const bf16_t* W = even ? p.wt_ev_in + (size_t)j * 2560 * 1024 : p.wt_od_in + (size_t)j * 3584 * 1024;
    const bool last = (layer == 3);
    const int local = g.local, nlocal = g.nlocal;
    const int wn = __builtin_amdgcn_readfirstlane(otid() >> 6) & 1;
    constexpr int RT_PER_XCD = MROWS / (64 * TIN) / 8;
    const int nli = RT_PER_XCD * nct;
#define GIN_SKIP(li_) (last && ((li_) / nct == 0) && ((((li_) % nct) * 128 < 2048) || (((li_) % nct) * 128 >= 3072)))
    for (int xcd = g.xcd; xcd < NB; xcd += g.nx) {
    int li = local;
    while (li < nli && GIN_SKIP(li)) li += nlocal;
    bool pre = false;
    while (li < nli) {
        const int rtl = li / nct, ct = li - rtl * nct;
        const int rt = xcd * RT_PER_XCD + rtl;
        const int row0 = rt * (64 * TIN), col0 = ct * 128;
        const int c64 = col0 + wn * 64;
        const bool swap = even ? (col0 == 640 || col0 == 1920) : (col0 >= 2560 && col0 < 3072);
        f32x16 acc[2 * TIN];
        if (!do_epi) {
            gemm_mainloop<false, TIN, GPROBE>(p.h, W, row0, col0, acc, lds, false);
            float sm = 0.f;
#pragma unroll
            for (int i = 0; i < 2 * TIN; ++i)
#pragma unroll
                for (int e = 0; e < 16; ++e) sm += acc[i][e];
            if (sm == 12345.678f) p.mvec[0] = sm;
            li += nlocal;
            continue;
        }
        if (swap) gemm_mainloop<true, TIN>(p.h, W, row0, col0, acc, lds, pre);
        else gemm_mainloop<false, TIN>(p.h, W, row0, col0, acc, lds, pre);
        int ln = li + nlocal;
        while (ln < nli && GIN_SKIP(ln)) ln += nlocal;
        pre = ln < nli;
        if (pre) { const int rtl2 = ln / nct, ct2 = ln - rtl2 * nct; gemm_prefetch<TIN>(p.h, W, (xcd * RT_PER_XCD + rtl2) * (64 * TIN), ct2 * 128, lds); }
        li = ln;
        if (even) {
            if (swap) epi_v<TIN>(p, acc, row0, (col0 == 640 ? 0 : 2) + wn, 4);
            else if (col0 < 512) epi_qk<true, true, TIN>(p, acc, p.a_q_gain + j * 64, row0, p.qbuf + c64, 0, 4);
            else if (col0 < 640) epi_qk<true, false, TIN>(p, acc, p.a_k_gain + j * 64, row0, nullptr, wn, 4);
            else if (col0 < 1280) epi_plain<1, TIN>(acc, p.gbuf + (c64 - 768), 1024, row0);
            else if (col0 < 1792) epi_qk<false, true, TIN>(p, acc, nullptr, row0, p.qbuf + 512 + (c64 - 1280), 0, 4);
            else if (col0 < 1920) epi_qk<false, false, TIN>(p, acc, nullptr, row0, nullptr, 2 + wn, 4);
            else epi_plain<1, TIN>(acc, p.gbuf + 512 + (c64 - 2048), 1024, row0);
        } else {
            if (swap) epi_v<TIN>(p, acc, row0, (c64 - 2560) >> 6, 8);
            else if (col0 < 1024) epi_glu<TIN>(acc, p.cbuf + 32 * (c64 >> 6), row0);
            else if (col0 < 1536) epi_plain<1, TIN>(acc, p.cbuf + c64, 1536, row0);
            else if (col0 < 2048) epi_plain<2, TIN>(acc, p.qbuf + (c64 - 1536), 512, row0);
            else if (col0 < 2560) epi_k_plain<TIN>(p, acc, row0, (c64 - 2048) >> 6, 8);
            else epi_plain<1, TIN>(acc, p.gbuf + (c64 - 3072), 512, row0);
        }
    }
    }
#undef GIN_SKIP
}

constexpr int TOUT = 2;
DI void gemm_out_phase(const Params& p, int layer, char* lds, const Grp& g) {
    const bool even = (layer & 1) == 0;
    const int j = layer >> 1;
    const bf16_t* W = (even ? p.wt_ev_out : p.wt_od_out) + (size_t)j * 1024 * 1024;
    const bool last = (layer == 3);
    const int local = g.local, nlocal = g.nlocal;
    constexpr int RT_PER_XCD = MROWS / (64 * TOUT) / 8;
    const int nli = RT_PER_XCD * 8;
#define GOUT_SKIP(li_) (last && ((li_) >> 3) < 2)
    for (int xcd = g.xcd; xcd < NB; xcd += g.nx) {
    int li = local;
    while (li < nli && GOUT_SKIP(li)) li += nlocal;
    bool pre = false;
    while (li < nli) {
        const int rtl = li >> 3, ct = li & 7;
        const int rt = xcd * RT_PER_XCD + rtl;
        const int row0 = rt * (64 * TOUT), col0 = ct * 128;
        f32x16 acc[2 * TOUT];
        gemm_mainloop<false, TOUT>(p.h  , W, row0, col0, acc, lds, pre);
        int ln = li + nlocal;
        while (ln < nli && GOUT_SKIP(ln)) ln += nlocal;
        pre = ln < nli;
        if (pre) gemm_prefetch<TOUT>(p.h, W, (xcd * RT_PER_XCD + (ln >> 3)) * (64 * TOUT), (ln & 7) * 128, lds);
        li = ln;
        const int lane = otid() & 63, w = __builtin_amdgcn_readfirstlane(otid() >> 6), wm = w >> 1, wn = w & 1, l31 = lane & 31, hh = lane >> 5;
#pragma unroll
        for (int ti = 0; ti < TOUT; ++ti) {
            const int r = row0 + wm * (32 * TOUT) + 32 * ti + l31;
            const int b = r / TB, t = r - b * TB;
            const int cond = (t < CTX) ? 8 : b;
            const float* gm = p.mvec + ((size_t)layer * 9 + cond) * 3072 + 2048;
            const float* xi = res_in_row(p, layer, r);
            float* xo = res_out_row(p, r);
#pragma unroll
            for (int fi = 0; fi < 2; ++fi)
#pragma unroll
                for (int g = 0; g < 4; ++g) {
                    const int c = col0 + wn * 64 + 32 * fi + 8 * g + 4 * hh;
                    const f32x4 xv = *(const f32x4*)(xi + c), gv = *(const f32x4*)(gm + c);
                    f32x4 o;
#pragma unroll
                    for (int e = 0; e < 4; ++e) o[e] = xv[e] + gv[e] * acc[fi * TOUT + ti][4 * g + e];
                    *(f32x4*)(xo + c) = o;
                }
        }
    }
    }
#undef GOUT_SKIP
}

template <int MODE>
DI void attn_block(char* lds, const bf16_t* __restrict__ Kb, const bf16_t* __restrict__ Vb, int nt, int lat_lo,
                   const bf16_t* __restrict__ qptr, int qstride, const bf16_t* __restrict__ gptr, int gstride, bf16_t* __restrict__ optr,
                   float sink_l2, int tq_base, const float* rpb_lds, int rq) {
    constexpr int ASTAGE = 16384, ANST = 3;
    const int tid = otid(), lane = tid & 63, w = __builtin_amdgcn_readfirstlane(tid >> 6), l31 = lane & 31, hh = lane >> 5;
    const int r8 = lane >> 3;
    const int cc = (lane & 7) ^ (4 * (w & 1) + (r8 >> 1));
    const unsigned kp = (unsigned)(((8 * w + r8) * 64 + cc * 8) * 2);
    const unsigned vp = (unsigned)(((8 * w + r8) * TB + cc * 8) * 2);
    const unsigned l3 = (unsigned)(size_t)lds + w * 1024;
#define ATT_ISSUE(itile, st) do { const int _t0 = ((itile) < 4) ? (itile) * 64 : CTX + lat_lo + ((itile) - 4) * 64; const unsigned _sb = l3 + (st) * ASTAGE; \
        dma16s(Kb, kp + _t0 * 128, _sb); dma16s(Kb, kp + (_t0 + 32) * 128, _sb + 4096); \
        dma16s(Vb, vp + _t0 * 2, _sb + 8192); dma16s(Vb, vp + (32 * TB + _t0) * 2, _sb + 8192 + 4096); } while (0)
    WAIT_BAR(0);
    ATT_ISSUE(0, 0);
    ATT_ISSUE(1, 1);
    bf16x8 qf[4];
#pragma unroll
    for (int ks = 0; ks < 4; ++ks) qf[ks] = *(const bf16x8*)(qptr + (size_t)l31 * qstride + 16 * ks + 8 * hh);
    asm volatile("" :: "v"(qf[0]), "v"(qf[1]), "v"(qf[2]), "v"(qf[3]));
    f32x16 O0, O1;
#pragma unroll
    for (int e = 0; e < 16; ++e) { O0[e] = 0.f; O1[e] = 0.f; }
    float mrun = (MODE == 1) ? sink_l2 : -1e30f;
    f32x16 Lacc;
#pragma unroll
    for (int e = 0; e < 16; ++e) Lacc[e] = (MODE == 1) ? 1.f : 0.f;
    const bf16x8 ones = __builtin_bit_cast(bf16x8, (u32x4){0x3F803F80u, 0x3F803F80u, 0x3F803F80u, 0x3F803F80u});
    const int tq = tq_base + l31;
    int cq = 0, cs_ = 0, rs = 0;
    if (MODE == 2) { cq = tq & 63; cs_ = min(max(cq - 8, 0), 48); rs = min(max(rq - 4, 0), 24); }
    const int swz = (l31 >> 1) & 7;
    const char* kbase = lds + l31 * 128;
    const char* vbase = lds + 8192 + l31 * 128;
    int rst = 0, ist = 2;
    if (MODE == 0) {
#define T15_QK(N0, N1, SLOT) do { const char* _k = kbase + (SLOT) * ASTAGE; \
            _Pragma("unroll") for (int e = 0; e < 16; ++e) { N0[e] = 0.f; N1[e] = 0.f; } \
            _Pragma("unroll") for (int ks = 0; ks < 4; ++ks) { const int ch = ((2 * ks + hh) ^ swz) * 16; \
                const bf16x8 k0 = *(const bf16x8*)(_k + ch), k1 = *(const bf16x8*)(_k + 32 * 128 + ch); \
                N0 = MFMA32(k0, qf[ks], N0); N1 = MFMA32(k1, qf[ks], N1); } } while (0)
#define T15_STEP(C0, C1, N0, N1, IT) do { \
            WAIT_BAR(0);                                     \
            if ((IT) + 2 < nt) { ATT_ISSUE((IT) + 2, ist); ist = (ist == 2) ? 0 : ist + 1; } \
            const char* ldsV = vbase + rst * ASTAGE; \
            rst = (rst == 2) ? 0 : rst + 1; \
            float mx = max3f(C0[0], C1[0], C0[1]); \
            _Pragma("unroll") for (int e = 1; e < 15; ++e) mx = max3f(mx, C1[e], C0[e + 1]); \
            mx = max3f(mx, C1[15], C1[15]) * LOG2E; \
            if (__any(mx > mrun + 8.0f)) { \
                const float mnew = max3f(mrun, mx, __shfl_xor(mx, 32)); \
                const float alpha = __builtin_amdgcn_exp2f(mrun - mnew); \
                _Pragma("unroll") for (int e = 0; e < 16; ++e) { O0[e] *= alpha; O1[e] *= alpha; Lacc[e] *= alpha; } \
                mrun = mnew; } \
            if ((IT) + 1 < nt) T15_QK(N0, N1, rst);          \
            _Pragma("unroll") for (int e = 0; e < 16; ++e) { \
                C0[e] = __builtin_amdgcn_exp2f(__builtin_fmaf(C0[e], LOG2E, -mrun)); \
                C1[e] = __builtin_amdgcn_exp2f(__builtin_fmaf(C1[e], LOG2E, -mrun)); } \
            if ((IT) + 1 < nt) { __builtin_amdgcn_sched_group_barrier(0x100, 8, 0); \
                _Pragma("unroll") for (int _g = 0; _g < 8; ++_g) { __builtin_amdgcn_sched_group_barrier(0x008, 1, 0); __builtin_amdgcn_sched_group_barrier(0x002, 8, 0); } } \
            _Pragma("unroll") for (int sub = 0; sub < 2; ++sub) \
            _Pragma("unroll") for (int sx = 0; sx < 2; ++sx) { \
                u32x4 pa; \
                if (sub == 0) { pa[0] = pk2(C0[8 * sx + 0], C0[8 * sx + 1]); pa[1] = pk2(C0[8 * sx + 2], C0[8 * sx + 3]); pa[2] = pk2(C0[8 * sx + 4], C0[8 * sx + 5]); pa[3] = pk2(C0[8 * sx + 6], C0[8 * sx + 7]); } \
                else          { pa[0] = pk2(C1[8 * sx + 0], C1[8 * sx + 1]); pa[1] = pk2(C1[8 * sx + 2], C1[8 * sx + 3]); pa[2] = pk2(C1[8 * sx + 4], C1[8 * sx + 5]); pa[3] = pk2(C1[8 * sx + 6], C1[8 * sx + 7]); } \
                const bf16x8 pfr = __builtin_bit_cast(bf16x8, pa); \
                const int ch = ((2 * (2 * sub + sx) + hh) ^ swz) * 16; \
                const bf16x8 v0 = *(const bf16x8*)(ldsV + ch), v1 = *(const bf16x8*)(ldsV + 32 * 128 + ch); \
                O0 = MFMA32(v0, pfr, O0); O1 = MFMA32(v1, pfr, O1); Lacc = MFMA32(ones, pfr, Lacc); } } while (0)
        f32x16 a0, a1, b0, b1;
        WAIT_BAR(4);
        T15_QK(a0, a1, 0);
#pragma unroll 1
        for (int it = 0; it < nt; it += 2) {
            T15_STEP(a0, a1, b0, b1, it);
            T15_STEP(b0, b1, a0, a1, it + 1);
        }
#undef T15_STEP
#undef T15_QK
    } else
#pragma unroll 1
    for (int it = 0; it < nt; ++it) {
        if (it + 1 < nt) WAIT_BAR(4); else WAIT_BAR(0);
        if (it + 2 < nt) { ATT_ISSUE(it + 2, ist); ist = (ist == 2) ? 0 : ist + 1; }
        const char* ldsK = kbase + rst * ASTAGE;
        const char* ldsV = vbase + rst * ASTAGE;
        rst = (rst == 2) ? 0 : rst + 1;
        bool active = true;
        int krow = 0;
        if (MODE == 2 && it >= 4) { krow = (lat_lo >> 6) + it - 4; active = (krow >= rs) && (krow < rs + 8); }
        if (active) {
            f32x16 s0, s1;
#pragma unroll
            for (int e = 0; e < 16; ++e) { s0[e] = 0.f; s1[e] = 0.f; }
            bf16x8 kf[2][4];
#pragma unroll
            for (int ks = 0; ks < 4; ++ks) {
                const int ch = ((2 * ks + hh) ^ swz) * 16;
                kf[0][ks] = *(const bf16x8*)(ldsK + ch);
                kf[1][ks] = *(const bf16x8*)(ldsK + 32 * 128 + ch);
            }
#pragma unroll
            for (int ks = 0; ks < 4; ++ks) {
                s0 = MFMA32(kf[0][ks], qf[ks], s0);
                s1 = MFMA32(kf[1][ks], qf[ks], s1);
            }
            bf16x8 vf[2][4];
#pragma unroll
            for (int q = 0; q < 4; ++q) {
                const int ch = ((2 * q + hh) ^ swz) * 16;
                vf[0][q] = *(const bf16x8*)(ldsV + ch);
                vf[1][q] = *(const bf16x8*)(ldsV + 32 * 128 + ch);
            }
            if (MODE != 2) {
                __builtin_amdgcn_sched_group_barrier(0x100, 8, 0);
                __builtin_amdgcn_sched_group_barrier(0x008, 8, 0);
                __builtin_amdgcn_sched_group_barrier(0x100, 8, 0);
            }
            const int kb_ = lat_lo + (it - 4) * 64;
            if (MODE == 1 && it >= 4 && !(kb_ >= tq_base - 97 && kb_ <= tq_base + 65)) {
                const int base = lat_lo + (it - 4) * 64 + 4 * hh - tq + 128;
#pragma unroll
                for (int e = 0; e < 16; ++e) {
                    const int o = (e >> 2) * 8 + (e & 3);
                    s0[e] = ((unsigned)(base + o) <= 256u) ? s0[e] : -1e30f;
                    s1[e] = ((unsigned)(base + 32 + o) <= 256u) ? s1[e] : -1e30f;
                }
            } else if (MODE == 2 && it >= 4) {
                const float* rpl = rpb_lds + (krow - rq + 7) * 31 + (4 * hh - cq + 15);
                const int vt = 4 * hh - cs_;
#pragma unroll
                for (int e = 0; e < 16; ++e) {
                    const int kcst = (e >> 2) * 8 + (e & 3);
                    const float b0 = rpl[kcst], b1 = rpl[kcst + 32];
                    s0[e] = ((unsigned)(kcst + vt) < 16u) ? (s0[e] + b0) : -1e30f;
                    s1[e] = ((unsigned)(kcst + 32 + vt) < 16u) ? (s1[e] + b1) : -1e30f;
                }
            }
            float mx = max3f(s0[0], s1[0], s0[1]);
#pragma unroll
            for (int e = 1; e < 15; ++e) mx = max3f(mx, s1[e], s0[e + 1]);
            mx = max3f(mx, s1[15], s1[15]) * LOG2E;
            if (__any(mx > mrun + 8.0f)) {
                const float mnew = max3f(mrun, mx, __shfl_xor(mx, 32));
                const float alpha = __builtin_amdgcn_exp2f(mrun - mnew);
#pragma unroll
                for (int e = 0; e < 16; ++e) { O0[e] *= alpha; O1[e] *= alpha; Lacc[e] *= alpha; }
                mrun = mnew;
            }
#pragma unroll
            for (int e = 0; e < 16; ++e) {
                s0[e] = __builtin_amdgcn_exp2f(__builtin_fmaf(s0[e], LOG2E, -mrun));
                s1[e] = __builtin_amdgcn_exp2f(__builtin_fmaf(s1[e], LOG2E, -mrun));
            }
            bf16x8 pf[2][2];
#pragma unroll
            for (int s = 0; s < 2; ++s) {
                u32x4 a, b;
                a[0] = pk2(s0[8 * s + 0], s0[8 * s + 1]); a[1] = pk2(s0[8 * s + 2], s0[8 * s + 3]); a[2] = pk2(s0[8 * s + 4], s0[8 * s + 5]); a[3] = pk2(s0[8 * s + 6], s0[8 * s + 7]);
                b[0] = pk2(s1[8 * s + 0], s1[8 * s + 1]); b[1] = pk2(s1[8 * s + 2], s1[8 * s + 3]); b[2] = pk2(s1[8 * s + 4], s1[8 * s + 5]); b[3] = pk2(s1[8 * s + 6], s1[8 * s + 7]);
                pf[0][s] = __builtin_bit_cast(bf16x8, a); pf[1][s] = __builtin_bit_cast(bf16x8, b);
            }
#pragma unroll
            for (int sub = 0; sub < 2; ++sub)
#pragma unroll
                for (int s = 0; s < 2; ++s) {
                    O0 = MFMA32(vf[0][2 * sub + s], pf[sub][s], O0);
                    O1 = MFMA32(vf[1][2 * sub + s], pf[sub][s], O1);
                    Lacc = MFMA32(ones, pf[sub][s], Lacc);
                }
        }
    }
#undef ATT_ISSUE
    const float inv = 1.0f / Lacc[0];
    const bf16_t* gp = gptr + (size_t)l31 * gstride;
    bf16_t* op = optr + (size_t)l31 * 1024;
#pragma unroll
    for (int half = 0; half < 2; ++half)
#pragma unroll
        for (int pr = 0; pr < 2; ++pr) {
            unsigned pk[4];
#pragma unroll
            for (int q = 0; q < 2; ++q) {
                const int g = 2 * pr + q, d = 32 * half + 8 * g + 4 * hh;
                const u32x2 gg = *(const u32x2*)(gp + d);
                const float a0 = (half ? O1[4 * g] : O0[4 * g]), a1 = (half ? O1[4 * g + 1] : O0[4 * g + 1]), a2 = (half ? O1[4 * g + 2] : O0[4 * g + 2]), a3 = (half ? O1[4 * g + 3] : O0[4 * g + 3]);
                pk[2 * q] = pk2(a0 * inv * bf_lo(gg[0]), a1 * inv * bf_hi(gg[0]));
                pk[2 * q + 1] = pk2(a2 * inv * bf_lo(gg[1]), a3 * inv * bf_hi(gg[1]));
            }
            store_pair16(op + 32 * half + 16 * pr, hh, pk[0], pk[1], pk[2], pk[3]);
        }
}

DI void even_mix_phase(const Params& p, int layer, char* lds, const Grp& g) {
    const int j = layer >> 1;
    const bool upd = layer < 3;
    const int w = __builtin_amdgcn_readfirstlane(otid() >> 6);
    const int local = g.local, nlocal = g.nlocal;
    const int per_b = 256 + (upd ? 32 : 0);
    for (int xcd = g.xcd; xcd < NB; xcd += g.nx)
    for (int li = local; li < per_b; li += nlocal) {
        const int item = (li < 128) ? (xcd * 128 + li) : (li < 256) ? (1024 + xcd * 128 + (li - 128)) : (2048 + xcd * 32 + (li - 256));
        if (item < 2048) {
            const bool isB = item >= 1024;
            const int it2 = item & 1023;
            const int b = it2 >> 7, kvh = (it2 >> 6) & 1, qt = it2 & 63;
            const int slot = (isB ? 2 : 0) + kvh;
            const int head = kvh * 4 + w;
            const int col = (isB ? 512 : 0) + head * 64;
            const int r0 = b * TB + CTX + qt * 32;
            const bf16_t* Kb = p.kbuf + (size_t)(b * 4 + slot) * TB * 64;
            const bf16_t* Vb = p.vT + (size_t)(b * 4 + slot) * 64 * TB;
            const bf16_t* qp = p.qbuf + (size_t)r0 * 1024 + col;
            const bf16_t* gp = p.gbuf + (size_t)r0 * 1024 + col;
            bf16_t* op = p.h + (size_t)r0 * 1024 + col;
            if (!isB) attn_block<0>(lds, Kb, Vb, 36, 0, qp, 1024, gp, 1024, op, 0.f, qt * 32, nullptr, 0);
            else {
                const int q0 = qt * 32;
                const int lo = max(0, q0 - 128) & ~63;
                const int hi = (min(SEQ, q0 + 160) + 63) & ~63;
                attn_block<1>(lds, Kb, Vb, 4 + ((hi - lo) >> 6), lo, qp, 1024, gp, 1024, op, p.b_sink[j * 8 + head] * LOG2E, q0, nullptr, 0);
            }
        } else {
            const int idx = item - 2048;
            const int b = idx >> 5, slot = (idx >> 3) & 3, qt = idx & 7;
            const bool isB = slot >= 2;
            const int head = (slot & 1) * 4 + w;
            const int col = (isB ? 512 : 0) + head * 64;
            const int r0 = b * TB + qt * 32;
            const bf16_t* Kb = p.kbuf + (size_t)(b * 4 + slot) * TB * 64;
            const bf16_t* Vb = p.vT + (size_t)(b * 4 + slot) * 64 * TB;
            const bf16_t* qp = p.qbuf + (size_t)r0 * 1024 + col;
            const bf16_t* gp = p.gbuf + (size_t)r0 * 1024 + col;
            bf16_t* op = p.h + (size_t)r0 * 1024 + col;
            if (!isB) attn_block<0>(lds, Kb, Vb, 4, 0, qp, 1024, gp, 1024, op, 0.f, 0, nullptr, 0);
            else attn_block<1>(lds, Kb, Vb, 4, 0, qp, 1024, gp, 1024, op, p.b_sink[j * 8 + head] * LOG2E, 0, nullptr, 0);
        }
    }
}

constexpr int CT = 16;
DI void conv_item(const Params& p, int j, int rbase  , int seglen, int t0, char* lds) {
    const int tid = otid(), lane = tid & 63, w = tid >> 6;
    const int c = 2 * tid;
    float wt[31][2];
    const float* wb = p.c_dw_w + (size_t)j * 31 * 512 + c;
    const bf16_t* cb = p.cbuf + (size_t)rbase * 1536 + c;
    asm volatile("" : "+v"(wb));
    asm volatile("" : "+v"(cb));
#pragma unroll
    for (int k = 0; k < 31; ++k) { const f32x2 v = *(const f32x2*)(wb + k * 512); wt[k][0] = v[0]; wt[k][1] = v[1]; }
    const f32x2 bias = *(const f32x2*)(p.c_dw_b + j * 512 + c);
    float acc[CT][2];
#pragma unroll
    for (int o = 0; o < CT; ++o) { acc[o][0] = bias[0]; acc[o][1] = bias[1]; }
#pragma unroll
    for (int i = 0; i < CT + 30; ++i) {
        const int pos = t0 - 15 + i;
        float u0 = 0.f, u1 = 0.f;
        if (pos >= 0 && pos < seglen) {
            const bf16_t* rp = cb + (ptrdiff_t)pos * 1536;
            const unsigned a = *(const unsigned*)rp;
            u0 = bf_lo(a); u1 = bf_hi(a);
        }
#pragma unroll
        for (int o = 0; o < CT; ++o) {
            const int k = i - o;
            if (k >= 0 && k < 31) { acc[o][0] += wt[k][0] * u0; acc[o][1] += wt[k][1] * u1; }
        }
    }
    float* red = (float*)lds;
    float* stat = red + CT * 8;
    __syncthreads();
#pragma unroll
    for (int o = 0; o < CT; ++o) {
        float s1 = acc[o][0] + acc[o][1], s2 = acc[o][0] * acc[o][0] + acc[o][1] * acc[o][1];
#pragma unroll
        for (int sh = 32; sh >= 1; sh >>= 1) { s1 += __shfl_xor(s1, sh); s2 += __shfl_xor(s2, sh); }
        if (lane == 0) { red[(o * 4 + w) * 2] = s1; red[(o * 4 + w) * 2 + 1] = s2; }
    }
    __syncthreads();
    if (tid < CT) {
        float s1 = 0.f, s2 = 0.f;
#pragma unroll
        for (int q = 0; q < 4; ++q) { s1 += red[(tid * 4 + q) * 2]; s2 += red[(tid * 4 + q) * 2 + 1]; }
        const float mean = s1 * (1.0f / 512.0f);
        const float var = fmaxf(s2 * (1.0f / 512.0f) - mean * mean, 0.f);
        stat[tid * 2] = mean; stat[tid * 2 + 1] = rsqrtf(var + EPS);
    }
    __syncthreads();
    const f32x2 lg = *(const f32x2*)(p.c_ln_g + j * 512 + c), lb = *(const f32x2*)(p.c_ln_b + j * 512 + c);
#pragma unroll
    for (int o = 0; o < CT; ++o) {
        const f32x2 st = *(const f32x2*)(stat + 2 * o);
        const float mean = st[0], rstd = st[1];
        const size_t r = (size_t)(rbase + t0 + o);
        const unsigned sg = *(const unsigned*)(cb + (ptrdiff_t)(t0 + o) * 1536 + 1024);
        const float y0 = silu_f((acc[o][0] - mean) * rstd * lg[0] + lb[0]) * bf_lo(sg);
        const float y1 = silu_f((acc[o][1] - mean) * rstd * lg[1] + lb[1]) * bf_hi(sg);
        *(unsigned*)(p.h + r * 1024 + c) = pk2(y0, y1);
    }
}

DI void odd_mix_phase(const Params& p, int layer, char* lds, const Grp& g) {
    const int j = layer >> 1;
    const bool upd = layer < 3;
    const int tid = otid(), w = __builtin_amdgcn_readfirstlane(tid >> 6);
    constexpr int NCL = NB * SEQ / CT, NCC = NB * CTX / CT, I1 = 1024 + NCL, I2 = I1 + 128;
    const int total = I1 + (upd ? 128 + NCC : 0); (void)total;
    const int local = g.local, nlocal = g.nlocal;
    constexpr int PCL = NCL / NB, PCC = NCC / NB;
    const int per_b = 128 + PCL + (upd ? 16 + PCC : 0);
    float* rpb_lds = (float*)(lds + 3 * 16384) + 64;
    for (int xcd = g.xcd; xcd < NB; xcd += g.nx)
    for (int li = local; li < per_b; li += nlocal) {
        const int item = (li < 128) ? (xcd * 128 + li) : (li < 128 + PCL) ? (1024 + xcd * PCL + (li - 128)) : (li < 128 + PCL + 16) ? (I1 + xcd * 16 + (li - 128 - PCL)) : (I2 + xcd * PCC + (li - 128 - PCL - 16));
        if (item < 1024) {
            const int b = item >> 7, hd = (item >> 4) & 7, rp = item & 15;
            __syncthreads();
            for (int i = tid; i < 465 + 128; i += 256) { const int k = i - 64; rpb_lds[k] = (k >= 0 && k < 465) ? p.d_rpb[((size_t)j * 8 + hd) * 465 + k] : 0.f; }
            const int rq = 2 * rp + (w >> 1);
            const int lo_row = min(max(2 * rp - 4, 0), 24), hi_row = min(max(2 * rp + 1 - 4, 0), 24) + 8;
            const int tq0 = rq * 64 + (w & 1) * 32;
            const int r0 = b * TB + CTX + tq0;
            const bf16_t* Kb = p.kbuf + (size_t)(b * 8 + hd) * TB * 64;
            const bf16_t* Vb = p.vT + (size_t)(b * 8 + hd) * 64 * TB;
            attn_block<2>(lds, Kb, Vb, 4 + (hi_row - lo_row), lo_row * 64, p.qbuf + (size_t)r0 * 512 + hd * 64, 512, p.gbuf + (size_t)r0 * 512 + hd * 64, 512,
                          p.h + (size_t)r0 * 1024 + 512 + hd * 64, 0.f, tq0, rpb_lds, rq);
        } else if (item >= I1 && item < I2) {
            const int idx = item - I1, b = idx >> 4, hd = (idx >> 1) & 7, half = idx & 1;
            const int r0 = b * TB + half * 128 + w * 32;
            const bf16_t* Kb = p.kbuf + (size_t)(b * 8 + hd) * TB * 64;
            const bf16_t* Vb = p.vT + (size_t)(b * 8 + hd) * 64 * TB;
            attn_block<0>(lds, Kb, Vb, 4, 0, p.qbuf + (size_t)r0 * 512 + hd * 64, 512, p.gbuf + (size_t)r0 * 512 + hd * 64, 512,
                          p.h + (size_t)r0 * 1024 + 512 + hd * 64, 0.f, 0, nullptr, 0);
        } else {
            int rbase, seglen, t0;
            if (item < I1) { const int idx = item - 1024; rbase = (idx / (SEQ / CT)) * TB + CTX; seglen = SEQ; t0 = (idx % (SEQ / CT)) * CT; }
            else { const int idx = item - I2; rbase = (idx / (CTX / CT)) * TB; seglen = CTX; t0 = (idx % (CTX / CT)) * CT; }
            conv_item(p, j, rbase, seglen, t0, lds);
        }
    }
}

#ifndef PMASK
#define PMASK 0xff
#endif
DI void run_phase(const Params& p, int ph, char* lds, const Grp& g) {
    if (ph == 0) { phase0(p, lds); return; }
    if (ph == 17) { final_phase(p, g); return; }
    const int layer = (ph - 1) >> 2, sub = (ph - 1) & 3;
    if (sub == 0) norm_phase(p, layer, g);
    else if (sub == 1) gemm_in_phase(p, layer, lds, g);
    else if (sub == 2) { if (layer & 1) odd_mix_phase(p, layer, lds, g); else even_mix_phase(p, layer, lds, g); }
    else gemm_out_phase(p, layer, lds, g);
}

__global__ void __launch_bounds__(256, 2) fwd_kernel(Params p, int ph0, int ph1) {
    __shared__ __attribute__((aligned(16))) char lds[LDS_BYTES];
    __shared__ uint4 xb_words;
    XcdBarrier xb;
    const bool multi = (ph1 - ph0) > 1;
    Grp g; g.xcd = blockIdx.x & 7; g.local = blockIdx.x >> 3; g.nlocal = gridDim.x >> 3; g.nx = 8;
    if (multi) {
        if (threadIdx.x == 0) xb_words = make_uint4(0u, 0u, 0u, 0u);
        __syncthreads();
        xb = xcd_barrier_post(p.bar, (volatile LAS unsigned*)&xb_words);
    }
#ifdef CLOCK_PROBE
    const unsigned long long ct0 = __builtin_amdgcn_s_memtime(), cr0 = __builtin_amdgcn_s_memrealtime();
#endif
    for (int ph = ph0; ph < ph1; ++ph) {
        if (ph > ph0) {
            if (ph == ph0 + 1) {
                xcd_barrier(xb);
                g.nlocal = (int)xb.st[0]; g.nx = (int)xb.st[1]; g.xcd = (int)xb.st[2]; g.local = (int)xb.st[3];
            } else xcc_barrier(xb);
        }
        run_phase(p, ph, lds, g);
    }
#ifdef CLOCK_PROBE
    if (blockIdx.x == 0 && threadIdx.x == 0) {
        const unsigned long long ct1 = __builtin_amdgcn_s_memtime(), cr1 = __builtin_amdgcn_s_memrealtime();
        const unsigned long long mhz = (ct1 - ct0) * 100ull / (cr1 - cr0 + 1ull);
        const unsigned long long extra = mhz * 10ull;
        while (__builtin_amdgcn_s_memrealtime() - cr1 < extra) __builtin_amdgcn_s_sleep(8);
    }
#endif
}

extern "C" void kernel_launch(void* const* d_in, const int* in_sizes, int n_in, void* d_out, int out_size, void* d_ws, size_t ws_size, hipStream_t stream) {
    Params p{};
    p.x = (const float*)d_in[0]; p.c = (const float*)d_in[1]; p.ctx = (const float*)d_in[2]; p.c_ctx = (const float*)d_in[3];
    p.mod_w = (const float*)d_in[4]; p.mod_b = (const float*)d_in[5]; p.norm_g = (const float*)d_in[6];
    p.ev_w_in = (const float*)d_in[7]; p.ev_w_out = (const float*)d_in[8]; p.a_q_gain = (const float*)d_in[9]; p.a_k_gain = (const float*)d_in[10]; p.b_sink = (const float*)d_in[11];
    p.od_w_in = (const float*)d_in[12]; p.od_w_out = (const float*)d_in[13]; p.c_dw_w = (const float*)d_in[14]; p.c_dw_b = (const float*)d_in[15];
    p.c_ln_g = (const float*)d_in[16]; p.c_ln_b = (const float*)d_in[17]; p.d_rpb = (const float*)d_in[18]; p.final_g = (const float*)d_in[19];
    p.out = (float*)d_out;
    char* ws = (char*)d_ws; size_t off = 0;
    auto take = [&](size_t bytes) { char* r = ws + off; off += (bytes + 255) & ~(size_t)255; return r; };
    p.bar = (unsigned*)take(XCD_BAR_WORDS * 4);
    p.mvec = (float*)take((size_t)4 * 9 * 3072 * 4);
    p.rope = (float*)take((size_t)2048 * 64 * 4);
    p.wt_ev_in = (bf16_t*)take((size_t)2 * 2560 * 1024 * 2);
    p.wt_ev_out = (bf16_t*)take((size_t)2 * 1024 * 1024 * 2);
    p.wt_od_in = (bf16_t*)take((size_t)2 * 3584 * 1024 * 2);
    p.wt_od_out = (bf16_t*)take((size_t)2 * 1024 * 1024 * 2);
    p.xctx = (float*)take((size_t)NB * CTX * DM * 4);
    p.h = (bf16_t*)take((size_t)MROWS * 1024 * 2);
    p.qbuf = (bf16_t*)take((size_t)MROWS * 1024 * 2);
    p.gbuf = (bf16_t*)take((size_t)MROWS * 1024 * 2);
    p.cbuf = (bf16_t*)take((size_t)MROWS * 1536 * 2);
    p.kbuf = (bf16_t*)take((size_t)NB * 8 * TB * 64 * 2);
    p.vT = (bf16_t*)take((size_t)NB * 8 * 64 * TB * 2);
    if (off > ws_size) { fprintf(stderr, "workspace too small: need %zu have %zu\n", off, ws_size); return; }

    static int grid_blocks = 0;
    if (!grid_blocks) {
        int dev = 0, cus = 0, per_cu = 0;
        hipGetDevice(&dev);
        hipDeviceGetAttribute(&cus, hipDeviceAttributeMultiprocessorCount, dev);
        hipOccupancyMaxActiveBlocksPerMultiprocessor(&per_cu, fwd_kernel, 256, 0);
        if (per_cu > 2) per_cu = 2;
        if (per_cu < 1) per_cu = 1;
        grid_blocks = cus * per_cu;
        grid_blocks &= ~7;
    }
#if MULTI_LAUNCH
    for (int ph = 0; ph < 18; ++ph) hipLaunchKernelGGL(fwd_kernel, dim3(grid_blocks), dim3(256), 0, stream, p, ph, ph + 1);
#else
    hipMemsetAsync(p.bar, 0, XCD_BAR_WORDS * 4, stream);
    int ph0 = 0, ph1 = 18;
    void* args[] = {&p, &ph0, &ph1};
    hipError_t e = hipLaunchCooperativeKernel((void*)fwd_kernel, dim3(grid_blocks), dim3(256), args, 0, stream);
    if (e != hipSuccess) fprintf(stderr, "cooperative launch failed: %s (grid %d)\n", hipGetErrorString(e), grid_blocks);
#endif
}
```
